# Optimizing an MI355X kernel written in HIP

```python
import math
import jax, jax.numpy as jnp
from jax import lax
import numpy as np

D_MODEL = 1024
BATCH = 4
SEQ = 8192
DEPTH = 2

GRID_W = 64
D_MIX = D_MODEL
GDN_WIDTH = D_MIX // 2
NA_WIDTH = D_MIX - GDN_WIDTH
GDN_HEAD_DIM = 128
GDN_HEADS = GDN_WIDTH // GDN_HEAD_DIM
NA_HEAD_DIM = 64
NA_HEADS = NA_WIDTH // NA_HEAD_DIM
CONV_WIDTH = 5
GDN_CHUNK = 64
GDN_CONV_CH = 3 * GDN_WIDTH
NA_WIN_R = 8
NA_WIN_C = 16
NA_QBLK_C = 16
NA_KSPAN_C = NA_QBLK_C + NA_WIN_C
D_FF = 4 * D_MODEL
DEEPNORM_ALPHA = (2 * DEPTH) ** 0.25
DEEPNORM_BETA = (8 * DEPTH) ** -0.25
LN_EPS = 1e-5
RMS_EPS = 1e-6
SPLIT_POINTS = (3 * GDN_WIDTH, 4 * GDN_WIDTH, 4 * GDN_WIDTH + 2 * GDN_HEADS, 4 * GDN_WIDTH + 4 * GDN_HEADS)
D_IN = 4 * GDN_WIDTH + 4 * GDN_HEADS + 3 * NA_WIDTH

kernel_name = "hybrid_gdn_natten_deepnorm_encoder"


def layer_norm(x, g, b):
    xf = x.astype(jnp.float32)
    mu = jnp.mean(xf, axis=-1, keepdims=True)
    var = jnp.mean(jnp.square(xf - mu), axis=-1, keepdims=True)
    y = (xf - mu) * lax.rsqrt(var + LN_EPS)
    return (y * g + b).astype(x.dtype)


def rms_norm(x, g):
    xf = x.astype(jnp.float32)
    y = xf * lax.rsqrt(jnp.mean(jnp.square(xf), axis=-1, keepdims=True) + RMS_EPS)
    return y * g


def l2_normalize(x):
    xf = x.astype(jnp.float32)
    return xf * lax.rsqrt(jnp.sum(jnp.square(xf), axis=-1, keepdims=True) + RMS_EPS)


def short_conv(x, w):
    pad = CONV_WIDTH // 2
    T = x.shape[1]
    xp = jnp.pad(x, ((0, 0), (pad, pad), (0, 0)))
    return sum(xp[:, i:i + T] * w[i] for i in range(CONV_WIDTH))


def gated_delta_chunked(q, k, v, g, beta):
    out_dtype = v.dtype
    B, T, H, dk = q.shape
    dv = v.shape[-1]
    C = GDN_CHUNK
    N = T // C
    f32 = jnp.float32

    def chunk(t):
        t = t.astype(f32).reshape((B, N, C, H) + t.shape[3:])
        return jnp.moveaxis(t, 3, 1)

    q = chunk(q) * (dk ** -0.5)
    k = chunk(k)
    v = chunk(v)
    g = chunk(g)
    beta = chunk(beta)
    gc = jnp.cumsum(g, axis=-1)
    lower = jnp.tril(jnp.ones((C, C), dtype=bool))
    strict = jnp.tril(jnp.ones((C, C), dtype=bool), -1)
    gamma = jnp.exp(jnp.where(lower, gc[..., :, None] - gc[..., None, :], -jnp.inf))
    kb = k * beta[..., None]
    a_mat = jnp.where(strict, jnp.einsum('bhncd,bhnsd->bhncs', kb, k) * gamma, 0.0)
    t_mat = a_mat + jnp.eye(C, dtype=f32)
    u = lax.linalg.triangular_solve(t_mat, v * beta[..., None], left_side=True, lower=True, unit_diagonal=True)
    w = lax.linalg.triangular_solve(t_mat, kb * jnp.exp(gc)[..., None], left_side=True, lower=True, unit_diagonal=True)
    qk = jnp.einsum('bhncd,bhnsd->bhncs', q, k) * gamma
    q_dec = q * jnp.exp(gc)[..., None]
    k_dec = k * jnp.exp(gc[..., -1:] - gc)[..., None]
    g_last = jnp.exp(gc[..., -1])
    xs = tuple(jnp.moveaxis(t, 2, 0) for t in (q_dec, k_dec, u, w, qk, g_last))

    def step(S, inp):
        qd, kd, u_n, w_n, qk_n, gl = inp
        v_new = u_n - jnp.einsum('bhck,bhkv->bhcv', w_n, S)
        o = jnp.einsum('bhck,bhkv->bhcv', qd, S) + jnp.einsum('bhcs,bhsv->bhcv', qk_n, v_new)
        S = S * gl[..., None, None] + jnp.einsum('bhck,bhcv->bhkv', kd, v_new)
        return S, o

    S0 = jnp.zeros((B, H, dk, dv), f32)
    _, o = lax.scan(step, S0, xs)
    o = jnp.transpose(o, (1, 0, 3, 2, 4)).reshape(B, T, H, dv)
    return o.astype(out_dtype)


def gdn_mixer(h_qkv, h_z, h_a, h_b, conv_w, a_log, dt_bias, norm_g):
    B, T, _ = h_qkv.shape
    qkv = jax.nn.silu(short_conv(h_qkv, conv_w))
    q, k, v = jnp.split(qkv, 3, axis=-1)
    q = l2_normalize(q.reshape(B, T, GDN_HEADS, GDN_HEAD_DIM))
    k = l2_normalize(k.reshape(B, T, GDN_HEADS, GDN_HEAD_DIM))
    v = v.reshape(B, T, GDN_HEADS, GDN_HEAD_DIM)
    a = h_a.astype(jnp.float32).reshape(B, T, 2, GDN_HEADS)
    b = h_b.astype(jnp.float32).reshape(B, T, 2, GDN_HEADS)
    g = -jnp.exp(a_log.astype(jnp.float32)) * jax.nn.softplus(a + dt_bias.astype(jnp.float32))
    beta = jax.nn.sigmoid(b)
    q2 = jnp.concatenate([q, q[:, ::-1]], axis=0)
    k2 = jnp.concatenate([k, k[:, ::-1]], axis=0)
    v2 = jnp.concatenate([v, v[:, ::-1]], axis=0)
    g2 = jnp.concatenate([g[:, :, 0], g[:, ::-1, 1]], axis=0)
    beta2 = jnp.concatenate([beta[:, :, 0], beta[:, ::-1, 1]], axis=0)
    o2 = gated_delta_chunked(q2, k2, v2, g2, beta2)
    o = o2[:B].astype(jnp.float32) + o2[B:, ::-1].astype(jnp.float32)
    z = h_z.reshape(B, T, GDN_HEADS, GDN_HEAD_DIM).astype(jnp.float32)
    o = rms_norm(o, norm_g) * jax.nn.silu(z)
    return o.reshape(B, T, GDN_WIDTH).astype(h_qkv.dtype)


def _na_column_tables():
    n_blk = GRID_W // NA_QBLK_C
    j = np.arange(n_blk)
    span_start = np.clip(j * NA_QBLK_C - NA_WIN_C // 2, 0, GRID_W - NA_KSPAN_C)
    key_cols = span_start[:, None] + np.arange(NA_KSPAN_C)[None, :]
    q_cols = j[:, None] * NA_QBLK_C + np.arange(NA_QBLK_C)[None, :]
    win_start = np.clip(q_cols - NA_WIN_C // 2, 0, GRID_W - NA_WIN_C)
    kc = key_cols[:, None, :]
    in_win = (kc >= win_start[:, :, None]) & (kc < win_start[:, :, None] + NA_WIN_C)
    rel_idx = np.clip(kc - q_cols[:, :, None] + NA_WIN_C - 1, 0, 2 * NA_WIN_C - 2)
    return key_cols, in_win, rel_idx


def neighborhood_attention(q, k, v, rpb):
    B, T, H, d = q.shape
    rows = T // GRID_W
    kr = min(NA_WIN_R, rows)
    n_blk = GRID_W // NA_QBLK_C
    key_cols, in_win, rel_idx = _na_column_tables()
    qg = q.reshape(B, rows, n_blk, NA_QBLK_C, H, d)
    kg = k.reshape(B, rows, GRID_W, H, d)
    vg = v.reshape(B, rows, GRID_W, H, d)
    scale = d ** -0.5
    mask = jnp.asarray(in_win)[None, None, :, :, None, :]
    rpb_cols = rpb.astype(jnp.float32)[:, :, rel_idx]

    def one_row(r):
        r0 = jnp.clip(r - kr // 2, 0, rows - kr)
        k_band = lax.dynamic_slice_in_dim(kg, r0, kr, axis=1)[:, :, key_cols]
        v_band = lax.dynamic_slice_in_dim(vg, r0, kr, axis=1)[:, :, key_cols]
        q_row = lax.dynamic_index_in_dim(qg, r, axis=1, keepdims=False)
        s = jnp.einsum('bjqhd,brjkhd->bhjqrk', q_row, k_band).astype(jnp.float32) * scale
        dr = r0 + jnp.arange(kr) - r + NA_WIN_R - 1
        bias = jnp.take(rpb_cols, dr, axis=1)
        s = s + jnp.transpose(bias, (0, 2, 3, 1, 4))[None]
        s = jnp.where(mask, s, -jnp.inf)
        p = jax.nn.softmax(s.reshape(s.shape[:4] + (kr * NA_KSPAN_C,)), axis=-1).reshape(s.shape)
        o = jnp.einsum('bhjqrk,brjkhd->bjqhd', p.astype(v.dtype), v_band)
        return o.reshape(B, GRID_W, H, d)

    out = lax.map(one_row, jnp.arange(rows))
    return jnp.transpose(out, (1, 0, 2, 3, 4)).reshape(B, T, H, d)


def setup_inputs(seed: int = 0) -> dict:
    key = jax.random.key(seed)
    ks = jax.random.split(key, 20)
    f32 = jnp.float32

    def nrm(k, shape, scale):
        return jax.random.normal(k, shape, f32) * scale

    x = nrm(ks[0], (BATCH, SEQ, D_MODEL), 1.0)
    ln_in_g = 1.0 + nrm(ks[1], (D_MODEL,), 0.02)
    ln_in_b = nrm(ks[2], (D_MODEL,), 0.02)
    w_in = nrm(ks[3], (DEPTH, D_MODEL, D_IN), D_MODEL ** -0.5)
    conv_w = nrm(ks[4], (DEPTH, CONV_WIDTH, GDN_CONV_CH), CONV_WIDTH ** -0.5)
    a_log = jnp.log(jax.random.uniform(ks[5], (DEPTH, 2, GDN_HEADS), f32, 1.0, 16.0))
    dt = jnp.exp(jax.random.uniform(ks[6], (DEPTH, 2, GDN_HEADS), f32, math.log(1e-3), math.log(1e-1)))
    dt_bias = dt + jnp.log(-jnp.expm1(-dt))
    gdn_norm_g = 1.0 + nrm(ks[7], (DEPTH, GDN_HEAD_DIM), 0.02)
    rpb = nrm(ks[8], (DEPTH, NA_HEADS, 2 * NA_WIN_R - 1, 2 * NA_WIN_C - 1), 0.1)
    na_norm_g = 1.0 + nrm(ks[9], (DEPTH, NA_HEAD_DIM), 0.02)
    w_out = nrm(ks[10], (DEPTH, D_MIX, D_MODEL), D_MIX ** -0.5 * DEEPNORM_BETA)
    ln1_g = 1.0 + nrm(ks[11], (DEPTH, D_MODEL), 0.02)
    ln1_b = nrm(ks[12], (DEPTH, D_MODEL), 0.02)
    w1 = nrm(ks[13], (DEPTH, D_MODEL, D_FF), D_MODEL ** -0.5)
    b1 = nrm(ks[14], (DEPTH, D_FF), 0.01)
    w2 = nrm(ks[15], (DEPTH, D_FF, D_MODEL), D_FF ** -0.5 * DEEPNORM_BETA)
    b2 = nrm(ks[16], (DEPTH, D_MODEL), 0.01)
    ln2_g = 1.0 + nrm(ks[17], (DEPTH, D_MODEL), 0.02)
    ln2_b = nrm(ks[18], (DEPTH, D_MODEL), 0.02)
    return {"x": x, "ln_in_g": ln_in_g, "ln_in_b": ln_in_b, "w_in": w_in, "conv_w": conv_w,
            "a_log": a_log, "dt_bias": dt_bias, "gdn_norm_g": gdn_norm_g, "rpb": rpb,
            "na_norm_g": na_norm_g, "w_out": w_out, "ln1_g": ln1_g, "ln1_b": ln1_b,
            "w1": w1, "b1": b1, "w2": w2, "b2": b2, "ln2_g": ln2_g, "ln2_b": ln2_b}


def reference(x, ln_in_g, ln_in_b, w_in, conv_w, a_log, dt_bias, gdn_norm_g, rpb,
              na_norm_g, w_out, ln1_g, ln1_b, w1, b1, w2, b2, ln2_g, ln2_b):
    B, T, _ = x.shape
    x = layer_norm(x, ln_in_g, ln_in_b)
    for l in range(DEPTH):
        h = jnp.einsum('btd,de->bte', x, w_in[l])
        h_qkv, h_z, h_a, h_b, h_na = jnp.split(h, SPLIT_POINTS, axis=-1)
        o_gdn = gdn_mixer(h_qkv, h_z, h_a, h_b, conv_w[l], a_log[l], dt_bias[l], gdn_norm_g[l])
        q_na, k_na, v_na = (t.reshape(B, T, NA_HEADS, NA_HEAD_DIM) for t in jnp.split(h_na, 3, axis=-1))
        o_na = neighborhood_attention(q_na, k_na, v_na, rpb[l])
        o_na = rms_norm(o_na, na_norm_g[l]).reshape(B, T, NA_WIDTH).astype(x.dtype)
        mix = jnp.einsum('bte,ed->btd', jnp.concatenate([o_gdn, o_na], axis=-1), w_out[l])
        x = layer_norm(DEEPNORM_ALPHA * x + mix, ln1_g[l], ln1_b[l])
        ff = jnp.square(jax.nn.relu(jnp.einsum('btd,df->btf', x, w1[l]) + b1[l]))
        ff = jnp.einsum('btf,fd->btd', ff, w2[l]) + b2[l]
        x = layer_norm(DEEPNORM_ALPHA * x + ff, ln2_g[l], ln2_b[l])
    return x
```

```cpp
#include <hip/hip_runtime.h>
#include <hip/hip_cooperative_groups.h>
#include <cstdio>
#include <cstdint>
#include <cmath>
namespace pg8 {
#define PG8_LAS __attribute__((address_space(3)))
typedef unsigned short bf16_t;
typedef short bf16x8 __attribute__((ext_vector_type(8)));
typedef float f32x4 __attribute__((ext_vector_type(4)));
typedef unsigned u32x4 __attribute__((ext_vector_type(4)));
constexpr int BM = 256, BK = 64, HALF = 128, HTB = HALF * BK * 2  , STAGE_BYTES = 8 * HTB, NXCD = 8, WGM = 4;

__host__ __device__ __forceinline__ int lds_byte(int r, int c) { const int st = (r >> 4) * 2 + (c >> 5), rr = r & 15, cc = c & 31, ob = rr * 64 + cc * 2; return st * 1024 + (ob ^ (((ob >> 9) & 1) << 5)); }
__host__ __device__ __forceinline__ void stage_rc(int b, int& R, int& C) { const int st = b / 1024, sb = b % 1024, swz = sb ^ (((sb >> 9) & 1) << 5); R = (st >> 1) * 16 + swz / 64; C = (st & 1) * 32 + (swz % 64) / 2; }
__host__ __device__ __forceinline__ int perm32(int rho) { const int n = rho >> 4, i = rho & 15; return 8 * (i >> 2) + 4 * n + (i & 3); }

struct Unit { int pm, pn; };
struct Gemm { const bf16_t* A; const bf16_t* Bt; int M, N, K; };

struct StaticOrder {
    int nM, nN, nwg, G, c;
    __host__ __device__ void init(int M, int N, int G_, int c_) { nM = M / BM; nN = N / BM; nwg = nM * nN; G = G_; c = c_; }
    __host__ __device__ bool next(int i, Unit& u) const {
        const long L = (long)i * G + c; if (L >= nwg) return false;
        int wgid = (int)L; { const int q = nwg / NXCD, r = nwg % NXCD, xcd = wgid % NXCD, off = wgid / NXCD; wgid = (xcd < r ? xcd * (q + 1) : r * (q + 1) + (xcd - r) * q) + off; }
        const int nig = WGM * nN, gid = wgid / nig, fm = gid * WGM, gsz = (nM - fm) < WGM ? (nM - fm) : WGM;
        u.pm = fm + ((wgid % nig) % gsz); u.pn = (wgid % nig) / gsz; return true;
    }
    __device__ __forceinline__ void a_ready(const Unit&) const {}
    __device__ __forceinline__ void done(const Unit&) const {}
};

__device__ __forceinline__ unsigned cvt_pk_bf16(float lo, float hi) { unsigned r; asm volatile("v_cvt_pk_bf16_f32 %0, %1, %2" : "=v"(r) : "v"(lo), "v"(hi)); return r; }
typedef float f32x2 __attribute__((ext_vector_type(2)));
template <class Epi, class Sched, bool ALIGN_EPI = false, bool SP2 = false>
__device__ __forceinline__ void gemm_phase(PG8_LAS unsigned char* lds, const Gemm g, const Sched& S, const Epi& E) {
    int tid_ = threadIdx.x; asm volatile("" : "+v"(tid_)); const int tid = tid_, wid = __builtin_amdgcn_readfirstlane(tid >> 6), lane = tid & 63, wr = wid >> 2, wc = wid & 3, fr = lane & 15, fq = lane >> 4;
    const int K = g.K, nt = K / BK;
    unsigned voffA[2], voffB[2];
#pragma unroll
    for (int i = 0; i < 2; ++i) { int R, C; stage_rc(tid * 16 + i * 8192, R, C); const int Rb = Epi::PERM ? ((R & ~31) + perm32(R & 31)) : R;
        voffA[i] = (unsigned)(R * K + C) * 2u; voffB[i] = (unsigned)(Rb * K + C) * 2u; }
    const size_t kstep = (size_t)(BK * 2);
    const size_t hstep = (size_t)HALF * K * 2;
    const size_t tstep = 2 * hstep;
    const unsigned ldsw = (unsigned)wid * 1024u;
    const int aoff = lds_byte(wr * 64 + fr, fq * 8), boff = lds_byte(wc * 32 + fr, fq * 8);
#define PG8_SA(b, h) (((b) * 2 + (h)) * HTB)
#define PG8_SB(b, h) ((4 + (b) * 2 + (h)) * HTB)
#define PG8_STAGE(bufoff, gbase, voff) do { _Pragma("unroll") for (int _i = 0; _i < 2; ++_i) \
        __builtin_amdgcn_global_load_lds((const unsigned*)((const char*)(gbase) + (voff)[_i]), (PG8_LAS unsigned*)(lds + (bufoff) + ldsw + _i * 8192), 16, 0, 0); } while (0)
#define PG8_LDA(dst, b, h) do { _Pragma("unroll") for (int m = 0; m < 4; ++m) _Pragma("unroll") for (int k = 0; k < 2; ++k) dst[m][k] = *(const PG8_LAS bf16x8*)(lds + PG8_SA(b, h) + aoff + m * 2048 + k * 1024); } while (0)
#define PG8_LDB(dst, b, h) do { _Pragma("unroll") for (int n = 0; n < 2; ++n) _Pragma("unroll") for (int k = 0; k < 2; ++k) dst[n][k] = *(const PG8_LAS bf16x8*)(lds + PG8_SB(b, h) + boff + n * 2048 + k * 1024); } while (0)
#define PG8_MMA(ai, bj, At, Bt) do { __builtin_amdgcn_s_setprio(1); _Pragma("unroll") for (int m = 0; m < 4; ++m) _Pragma("unroll") for (int n = 0; n < 2; ++n) _Pragma("unroll") for (int k = 0; k < 2; ++k) \
        acc[ai][bj][m][n] = __builtin_amdgcn_mfma_f32_16x16x32_bf16(Bt[n][k], At[m][k], acc[ai][bj][m][n], 0, 0, 0); __builtin_amdgcn_s_setprio(0); } while (0)
#define PG8_WAIT_V(n) asm volatile("s_waitcnt vmcnt(" #n ")" ::: "memory")
#define PG8_WAIT_L(n) asm volatile("s_waitcnt lgkmcnt(" #n ")" ::: "memory")
#define PG8_BAR __builtin_amdgcn_s_barrier()
#define PG8_SCHED __builtin_amdgcn_sched_barrier(0)
    Unit cur, nxt; int ui = 0;
    if (!S.next(0, cur)) return;
    f32x4 acc[2][2][4][2];
#pragma unroll
    for (int a = 0; a < 2; ++a)
#pragma unroll
        for (int b = 0; b < 2; ++b)
#pragma unroll
            for (int m = 0; m < 4; ++m)
#pragma unroll
                for (int n = 0; n < 2; ++n) acc[a][b][m][n] = (f32x4){0.f, 0.f, 0.f, 0.f};
    bf16x8 At[4][2], B0[2][2], B1[2][2];
    const char* cA = (const char*)g.A + (size_t)cur.pm * tstep; const char* cB = (const char*)g.Bt + (size_t)cur.pn * tstep;
    S.a_ready(cur);
    if constexpr (SP2) {
        PG8_STAGE(PG8_SB(0, 0), cB, voffB); PG8_STAGE(PG8_SB(0, 1), cB + hstep, voffB); PG8_STAGE(PG8_SA(0, 0), cA, voffA); PG8_STAGE(PG8_SA(0, 1), cA + hstep, voffA);
        if (wr == 1) PG8_BAR;
        PG8_WAIT_V(2); PG8_BAR;
        PG8_STAGE(PG8_SB(1, 0), cB + kstep, voffB); PG8_STAGE(PG8_SA(1, 0), cA + kstep, voffA); PG8_STAGE(PG8_SB(1, 1), cB + hstep + kstep, voffB);
        PG8_WAIT_V(6); PG8_BAR;
    } else {
        PG8_STAGE(PG8_SB(0, 0), cB, voffB); PG8_STAGE(PG8_SA(0, 0), cA, voffA); PG8_STAGE(PG8_SB(0, 1), cB + hstep, voffB); PG8_STAGE(PG8_SA(0, 1), cA + hstep, voffA);
        if (wr == 1) PG8_BAR;
        PG8_WAIT_V(4); PG8_BAR;
        PG8_STAGE(PG8_SB(1, 0), cB + kstep, voffB); PG8_STAGE(PG8_SA(1, 0), cA + kstep, voffA); PG8_STAGE(PG8_SB(1, 1), cB + hstep + kstep, voffB);
        PG8_WAIT_V(6); PG8_BAR;
    }
    for (;;) {
        const bool has_next = S.next(ui + 1, nxt);
        const char* nA = has_next ? (const char*)g.A + (size_t)nxt.pm * tstep : cA; const char* nB = has_next ? (const char*)g.Bt + (size_t)nxt.pn * tstep : cB;
        for (int t = 0; t < nt; t += 2) {
            const bool last = (t == nt - 2);
            const char* a1 = cA + (size_t)(t + 1) * kstep;
            const char* a2 = last ? nA : cA + (size_t)(t + 2) * kstep; const char* b2 = last ? nB : cB + (size_t)(t + 2) * kstep;
            const char* a3 = a2 + kstep; const char* b3 = b2 + kstep;
            if (last && has_next) S.a_ready(nxt);
            if constexpr (SP2) {
            PG8_LDB(B0, 0, 0); PG8_LDB(B1, 0, 1); PG8_SCHED; PG8_LDA(At, 0, 0); PG8_STAGE(PG8_SA(1, 1), a1 + hstep, voffA);
            PG8_WAIT_V(8); PG8_WAIT_L(0); PG8_BAR; PG8_MMA(0, 0, At, B0); PG8_MMA(0, 1, At, B1); PG8_BAR; PG8_SCHED;
            PG8_LDA(At, 0, 1); PG8_STAGE(PG8_SB(0, 0), b2, voffB); PG8_STAGE(PG8_SB(0, 1), b2 + hstep, voffB); PG8_STAGE(PG8_SA(0, 0), a2, voffA);
            PG8_WAIT_V(8); PG8_WAIT_L(0); PG8_BAR; PG8_MMA(1, 0, At, B0); PG8_MMA(1, 1, At, B1); PG8_BAR; PG8_SCHED;
            PG8_LDB(B0, 1, 0); PG8_LDB(B1, 1, 1); PG8_SCHED; PG8_LDA(At, 1, 0); PG8_STAGE(PG8_SA(0, 1), a2 + hstep, voffA);
            PG8_WAIT_V(8); PG8_WAIT_L(0); PG8_BAR; PG8_MMA(0, 0, At, B0); PG8_MMA(0, 1, At, B1); PG8_BAR; PG8_SCHED;
            PG8_LDA(At, 1, 1); PG8_STAGE(PG8_SB(1, 0), b3, voffB); PG8_STAGE(PG8_SB(1, 1), b3 + hstep, voffB); PG8_STAGE(PG8_SA(1, 0), a3, voffA);
            PG8_WAIT_V(8); PG8_WAIT_L(0); PG8_BAR; PG8_MMA(1, 0, At, B0); PG8_MMA(1, 1, At, B1); PG8_BAR; PG8_SCHED;
            } else {
            PG8_LDB(B0, 0, 0); PG8_SCHED; PG8_LDA(At, 0, 0); PG8_STAGE(PG8_SA(1, 1), a1 + hstep, voffA);
            PG8_WAIT_L(8); PG8_BAR; PG8_WAIT_L(0); PG8_MMA(0, 0, At, B0); PG8_BAR; PG8_SCHED;
            PG8_LDB(B1, 0, 1); PG8_STAGE(PG8_SB(0, 0), b2, voffB);
            PG8_BAR; PG8_WAIT_L(0); PG8_MMA(0, 1, At, B1); PG8_BAR;
            PG8_LDA(At, 0, 1); PG8_STAGE(PG8_SA(0, 0), a2, voffA);
            PG8_BAR; PG8_WAIT_L(0); PG8_MMA(1, 0, At, B0); PG8_BAR; PG8_SCHED;
            PG8_STAGE(PG8_SB(0, 1), b2 + hstep, voffB);
            PG8_WAIT_V(6); PG8_BAR; PG8_MMA(1, 1, At, B1); PG8_BAR;
            PG8_LDB(B0, 1, 0); PG8_SCHED; PG8_LDA(At, 1, 0); PG8_STAGE(PG8_SA(0, 1), a2 + hstep, voffA);
            PG8_WAIT_L(8); PG8_BAR; PG8_WAIT_L(0); PG8_MMA(0, 0, At, B0); PG8_BAR; PG8_SCHED;
            PG8_LDB(B1, 1, 1); PG8_STAGE(PG8_SB(1, 0), b3, voffB);
            PG8_BAR; PG8_WAIT_L(0); PG8_MMA(0, 1, At, B1); PG8_BAR;
            PG8_LDA(At, 1, 1); PG8_STAGE(PG8_SA(1, 0), a3, voffA);
            PG8_BAR; PG8_WAIT_L(0); PG8_MMA(1, 0, At, B0); PG8_BAR; PG8_SCHED;
            PG8_STAGE(PG8_SB(1, 1), b3 + hstep, voffB);
            PG8_WAIT_V(6); PG8_BAR; PG8_MMA(1, 1, At, B1); PG8_BAR;
            }
        }
        if constexpr (ALIGN_EPI) { if (wr == 0) PG8_BAR; }
        if constexpr (!Epi::AFTER_DRAIN) { E(acc, cur, wr, wc, fr, fq); S.done(cur); }
        if (!has_next) break;
#pragma unroll
        for (int a = 0; a < 2; ++a)
#pragma unroll
            for (int b = 0; b < 2; ++b)
#pragma unroll
                for (int m = 0; m < 4; ++m)
#pragma unroll
                    for (int n = 0; n < 2; ++n) acc[a][b][m][n] = (f32x4){0.f, 0.f, 0.f, 0.f};
        cur = nxt; cA = nA; cB = nB; ++ui;
        if constexpr (ALIGN_EPI) { if (wr == 1) PG8_BAR; }
    }
    PG8_WAIT_V(0);
    if constexpr (!ALIGN_EPI) { if (wr == 0) PG8_BAR; }
    PG8_BAR;
    if constexpr (Epi::AFTER_DRAIN) { E.fused(acc, cur, wr, wc, fr, fq, lds, wid, lane); S.done(cur); }
#undef PG8_SA
#undef PG8_SB
#undef PG8_STAGE
#undef PG8_LDA
#undef PG8_LDB
#undef PG8_MMA
#undef PG8_WAIT_V
#undef PG8_WAIT_L
#undef PG8_BAR
#undef PG8_SCHED
}
}

namespace cg = cooperative_groups;
typedef unsigned short bf16;
typedef short bf16x8 __attribute__((ext_vector_type(8)));
typedef short s16x4 __attribute__((ext_vector_type(4)));
typedef float f32x4 __attribute__((ext_vector_type(4)));
typedef float f32x16 __attribute__((ext_vector_type(16)));
typedef unsigned u32x4 __attribute__((ext_vector_type(4)));
typedef unsigned u32x2 __attribute__((ext_vector_type(2)));
#define LAS __attribute__((address_space(3)))

constexpr int NB = 4, T = 8192, M = NB * T, D = 1024, FF = 4096;
constexpr int NIN = 3840;
constexpr float ALPHA = 1.41421356237309515f;
constexpr int LDS_BYTES = 147456;
constexpr int NSCAN = 64;

constexpr size_t MiB = 1u << 20;
constexpr size_t WS_WIN = 1 * MiB, WS_WOUT = 16 * MiB, WS_W1 = 20 * MiB, WS_W2 = 36 * MiB;
constexpr size_t WS_AB = 52 * MiB, WS_XN = 54 * MiB, WS_HZ = 118 * MiB, WS_HN = 150 * MiB, WS_HG = 246 * MiB;
constexpr size_t WS_RQ = 342 * MiB, WS_RK = 374 * MiB, WS_RV = 406 * MiB;
constexpr size_t WS_RTI = 438 * MiB, WS_RQK = 470 * MiB, WS_VEC = 502 * MiB;
constexpr size_t WS_HB = 150 * MiB;
constexpr size_t WS_YB = 406 * MiB;
constexpr size_t OUT_MIX = 64 * MiB;
constexpr size_t WS_END = 506 * MiB;

struct Params {
    const float *x, *ln_in_g, *ln_in_b, *w_in, *conv_w, *a_log, *dt_bias, *gdn_norm_g, *rpb, *na_norm_g, *w_out, *ln1_g, *ln1_b, *w1, *b1, *w2, *b2, *ln2_g, *ln2_b;
    float* out; unsigned char* ws;
};

typedef __bf16 bf16v2_t __attribute__((ext_vector_type(2)));
typedef float f32v2_t __attribute__((ext_vector_type(2)));
__device__ __forceinline__ unsigned pk2(float lo, float hi) { f32v2_t f = {lo, hi}; bf16v2_t b = __builtin_convertvector(f, bf16v2_t); return __builtin_bit_cast(unsigned, b); }
__device__ __forceinline__ unsigned short f2bf(float f) { return (unsigned short)(pk2(f, 0.f) & 0xffffu); }
__device__ __forceinline__ float bflo(unsigned u) { return __uint_as_float(u << 16); }
__device__ __forceinline__ float bfhi(unsigned u) { return __uint_as_float(u & 0xffff0000u); }
__device__ __forceinline__ int ppos(int o) { return (o & ~12) | ((o & 4) << 1) | ((o & 8) >> 1); }
__device__ __forceinline__ float wave_sum(float v) {
#pragma unroll
    for (int o = 1; o < 64; o <<= 1) v += __shfl_xor(v, o);
    return v;
}
__device__ __forceinline__ bf16x8 pack8(float a0, float a1, float a2, float a3, float a4, float a5, float a6, float a7) {
    u32x4 u; u.x = pk2(a0, a1); u.y = pk2(a2, a3); u.z = pk2(a4, a5); u.w = pk2(a6, a7);
    return __builtin_bit_cast(bf16x8, u);
}
#define MFMA32(a, b, c) __builtin_amdgcn_mfma_f32_32x32x16_bf16((a), (b), (c), 0, 0, 0)
#define MFMA16(a, b, c) __builtin_amdgcn_mfma_f32_16x16x32_bf16((a), (b), (c), 0, 0, 0)
typedef short v4i16_t __attribute__((ext_vector_type(4)));
__device__ __forceinline__ s16x4 trread(const LAS bf16* p) { return __builtin_bit_cast(s16x4, __builtin_amdgcn_ds_read_tr16_b64_v4i16((LAS v4i16_t*)p)); }
__device__ __forceinline__ bf16x8 cat8(s16x4 lo, s16x4 hi) { bf16x8 r; r[0] = lo[0]; r[1] = lo[1]; r[2] = lo[2]; r[3] = lo[3]; r[4] = hi[0]; r[5] = hi[1]; r[6] = hi[2]; r[7] = hi[3]; return r; }
#define LDS_BARRIER() do { asm volatile("s_waitcnt lgkmcnt(0)" ::: "memory"); __builtin_amdgcn_s_barrier(); asm volatile("" ::: "memory"); } while (0)
#define SBAR __builtin_amdgcn_sched_barrier(0)
#define WAVE_SYNC() do { __builtin_amdgcn_fence(__ATOMIC_RELEASE, "wavefront"); __builtin_amdgcn_wave_barrier(); __builtin_amdgcn_fence(__ATOMIC_ACQUIRE, "wavefront"); } while (0)

__device__ __forceinline__ int otid() { int t = threadIdx.x; asm volatile("" : "+v"(t)); return t; }
__device__ __forceinline__ int obid() { int t = blockIdx.x; asm volatile("" : "+s"(t)); return t; }

struct EpiIn {
    static constexpr bool PERM = true, AFTER_DRAIN = false;
    bf16 *HG, *HZ, *HN; float* AB;
    __device__ __forceinline__ void operator()(const f32x4 (&acc)[2][2][4][2], const pg8::Unit& u, int wr, int wc, int fr, int fq) const {
        const int row0 = u.pm * 256 + wr * 64 + fr;
        const int pn = u.pn;
        if (pn < 14) {
            bf16* base; int ldc, colt;
            if (pn < 6) { base = HG; ldc = 1536; colt = pn * 256; }
            else if (pn < 8) { base = HZ; ldc = 512; colt = (pn - 6) * 256; }
            else { base = HN; ldc = 1536; colt = (pn - 8) * 256; }
            const int col0 = colt + wc * 32 + 8 * fq;
#pragma unroll
            for (int ai = 0; ai < 2; ++ai)
#pragma unroll
                for (int m = 0; m < 4; ++m) {
                    bf16* rowp = base + (size_t)(row0 + ai * 128 + m * 16) * ldc + col0;
#pragma unroll
                    for (int bj = 0; bj < 2; ++bj) {
                        const f32x4 v0 = acc[ai][bj][m][0], v1 = acc[ai][bj][m][1];
                        u32x4 w; w.x = pk2(v0[0], v0[1]); w.y = pk2(v0[2], v0[3]); w.z = pk2(v1[0], v1[1]); w.w = pk2(v1[2], v1[3]);
                        *(u32x4*)(rowp + bj * 128) = w;
                    }
                }
        } else {
            if (wc == 0 && fq < 2) {
#pragma unroll
                for (int ai = 0; ai < 2; ++ai)
#pragma unroll
                    for (int m = 0; m < 4; ++m) {
                        float* rp = AB + (size_t)(row0 + ai * 128 + m * 16) * 16 + 8 * fq;
                        *(f32x4*)(rp) = acc[ai][0][m][0];
                        *(f32x4*)(rp + 4) = acc[ai][0][m][1];
                    }
            }
        }
    }
};
struct EpiUp {
    static constexpr bool PERM = true, AFTER_DRAIN = false;
    bf16* O; const float* bias;
    __device__ __forceinline__ void operator()(const f32x4 (&acc)[2][2][4][2], const pg8::Unit& u, int wr, int wc, int fr, int fq) const {
        const int row0 = u.pm * 256 + wr * 64 + fr;
        const int col0 = u.pn * 256 + wc * 32 + 8 * fq;
        f32x4 bv[2][2];
#pragma unroll
        for (int bj = 0; bj < 2; ++bj)
#pragma unroll
            for (int n = 0; n < 2; ++n) bv[bj][n] = *(const f32x4*)(bias + col0 + bj * 128 + 4 * n);
#pragma unroll
        for (int ai = 0; ai < 2; ++ai)
#pragma unroll
            for (int m = 0; m < 4; ++m) {
                bf16* rowp = O + (size_t)(row0 + ai * 128 + m * 16) * FF + col0;
#pragma unroll
                for (int bj = 0; bj < 2; ++bj) {
                    f32x4 v0 = acc[ai][bj][m][0] + bv[bj][0], v1 = acc[ai][bj][m][1] + bv[bj][1];
#pragma unroll
                    for (int e = 0; e < 4; ++e) { const float a = fmaxf(v0[e], 0.f), b = fmaxf(v1[e], 0.f); v0[e] = a * a; v1[e] = b * b; }
                    u32x4 w; w.x = pk2(v0[0], v0[1]); w.y = pk2(v0[2], v0[3]); w.z = pk2(v1[0], v1[1]); w.w = pk2(v1[2], v1[3]);
                    *(u32x4*)(rowp + bj * 128) = w;
                }
            }
    }
};
struct EpiRes {
    static constexpr bool PERM = true, AFTER_DRAIN = false;
    const bf16* XR; bf16* Y; const float* bias;
    __device__ __forceinline__ void operator()(const f32x4 (&acc)[2][2][4][2], const pg8::Unit& u, int wr, int wc, int fr, int fq) const {
        const int row0 = u.pm * 256 + wr * 64 + fr;
        const int col0 = u.pn * 256 + wc * 32 + 8 * fq;
#pragma unroll
        for (int ai = 0; ai < 2; ++ai)
#pragma unroll
            for (int m = 0; m < 4; ++m) {
                const size_t off = (size_t)(row0 + ai * 128 + m * 16) * D + col0;
#pragma unroll
                for (int bj = 0; bj < 2; ++bj) {
                    const u32x4 xr = *(const u32x4*)(XR + off + bj * 128);
                    f32x4 b0 = {0.f, 0.f, 0.f, 0.f}, b1 = {0.f, 0.f, 0.f, 0.f};
                    if (bias) { b0 = *(const f32x4*)(bias + col0 + bj * 128); b1 = *(const f32x4*)(bias + col0 + bj * 128 + 4); }
                    const f32x4 v0 = acc[ai][bj][m][0] + b0, v1 = acc[ai][bj][m][1] + b1;
                    u32x4 w;
                    w.x = pk2(ALPHA * bflo(xr.x) + v0[0], ALPHA * bfhi(xr.x) + v0[1]); w.y = pk2(ALPHA * bflo(xr.y) + v0[2], ALPHA * bfhi(xr.y) + v0[3]);
                    w.z = pk2(ALPHA * bflo(xr.z) + v1[0], ALPHA * bfhi(xr.z) + v1[1]); w.w = pk2(ALPHA * bflo(xr.w) + v1[2], ALPHA * bfhi(xr.w) + v1[3]);
                    *(u32x4*)(Y + off + bj * 128) = w;
                }
            }
    }
};

__device__ __forceinline__ void tr_item(const float* W, int ld, int K, int src_col0, int nvalid, bf16* WT, int dst_row0, LAS float* scr, int kb, int nb, int lane) {
    const int k0 = 64 * kb, n0 = 32 * nb;
    const int nq = (lane & 7) * 4, n = n0 + nq;
#pragma unroll
    for (int i = 0; i < 8; ++i) {
        const int kk = 8 * i + (lane >> 3);
        f32x4 v = {0.f, 0.f, 0.f, 0.f};
        if (n < nvalid) v = *(const f32x4*)(W + (size_t)(k0 + kk) * ld + src_col0 + n);
        scr[kk * 33 + nq + 0] = v[0]; scr[kk * 33 + nq + 1] = v[1]; scr[kk * 33 + nq + 2] = v[2]; scr[kk * 33 + nq + 3] = v[3];
    }
    WAVE_SYNC();
    const int c = lane & 7;
#pragma unroll
    for (int j = 0; j < 4; ++j) {
        const int nn = (lane >> 3) + 8 * j; const LAS float* s = scr + (8 * c) * 33 + nn;
        u32x4 o; o.x = pk2(s[0 * 33], s[1 * 33]); o.y = pk2(s[2 * 33], s[3 * 33]); o.z = pk2(s[4 * 33], s[5 * 33]); o.w = pk2(s[6 * 33], s[7 * 33]);
        *(u32x4*)(WT + (size_t)(dst_row0 + n0 + nn) * K + k0 + 8 * c) = o;
    }
    WAVE_SYNC();
}
__device__ __forceinline__ void ln_row(const float* src, float* dstf, bf16* dstb, const float* g, const float* b, int lane) {
    f32x4 v[4]; float s = 0.f;
#pragma unroll
    for (int j = 0; j < 4; ++j) { v[j] = *(const f32x4*)(src + 4 * lane + 256 * j); s += (v[j][0] + v[j][1]) + (v[j][2] + v[j][3]); }
    const float mean = wave_sum(s) * (1.f / D); float s2 = 0.f;
#pragma unroll
    for (int j = 0; j < 4; ++j) { v[j] = v[j] - mean; s2 += (v[j][0] * v[j][0] + v[j][1] * v[j][1]) + (v[j][2] * v[j][2] + v[j][3] * v[j][3]); }
    const float rstd = 1.0f / sqrtf(wave_sum(s2) * (1.f / D) + 1e-5f);
#pragma unroll
    for (int j = 0; j < 4; ++j) {
        const f32x4 gv = *(const f32x4*)(g + 4 * lane + 256 * j), bv = *(const f32x4*)(b + 4 * lane + 256 * j);
        const f32x4 y = v[j] * rstd * gv + bv;
        if (dstf) *(f32x4*)(dstf + 4 * lane + 256 * j) = y;
        if (dstb) { u32x2 w; w.x = pk2(y[0], y[1]); w.y = pk2(y[2], y[3]); *(u32x2*)(dstb + 4 * lane + 256 * j) = w; }
    }
}
__device__ __forceinline__ void ln_row_b(const bf16* src, float* dstf, bf16* dstb, const float* g, const float* b, int lane) {
    float v[16]; float s = 0.f;
#pragma unroll
    for (int j = 0; j < 2; ++j) {
        const u32x4 u = *(const u32x4*)(src + 8 * lane + 512 * j);
#pragma unroll
        for (int k = 0; k < 4; ++k) { v[8 * j + 2 * k] = bflo(u[k]); v[8 * j + 2 * k + 1] = bfhi(u[k]); }
    }
#pragma unroll
    for (int k = 0; k < 16; ++k) s += v[k];
    const float mean = wave_sum(s) * (1.f / D); float s2 = 0.f;
#pragma unroll
    for (int k = 0; k < 16; ++k) { v[k] -= mean; s2 += v[k] * v[k]; }
    const float rstd = 1.0f / sqrtf(wave_sum(s2) * (1.f / D) + 1e-5f);
#pragma unroll
    for (int j = 0; j < 2; ++j) {
        const f32x4 g0 = *(const f32x4*)(g + 8 * lane + 512 * j), g1 = *(const f32x4*)(g + 8 * lane + 512 * j + 4);
        const f32x4 b0 = *(const f32x4*)(b + 8 * lane + 512 * j), b1 = *(const f32x4*)(b + 8 * lane + 512 * j + 4);
        f32x4 y0, y1;
#pragma unroll
        for (int k = 0; k < 4; ++k) { y0[k] = v[8 * j + k] * rstd * g0[k] + b0[k]; y1[k] = v[8 * j + 4 + k] * rstd * g1[k] + b1[k]; }
        if (dstf) { *(f32x4*)(dstf + 8 * lane + 512 * j) = y0; *(f32x4*)(dstf + 8 * lane + 512 * j + 4) = y1; }
        if (dstb) { u32x4 w; w.x = pk2(y0[0], y0[1]); w.y = pk2(y0[2], y0[3]); w.z = pk2(y1[0], y1[1]); w.w = pk2(y1[2], y1[3]); *(u32x4*)(dstb + 8 * lane + 512 * j) = w; }
    }
}
__device__ __forceinline__ void ln_phase_b(const bf16* src, float* dstf, bf16* dstb, const float* g, const float* b) {
    const int lane = otid() & 63, gw = obid() * 8 + (otid() >> 6), ngw = gridDim.x * 8;
    for (int m = gw; m < M; m += ngw) ln_row_b(src + (size_t)m * D, dstf ? dstf + (size_t)m * D : nullptr, dstb ? dstb + (size_t)m * D : nullptr, g, b, lane);
}
__device__ __forceinline__ void ln_phase(const float* src, float* dstf, bf16* dstb, const float* g, const float* b) {
    const int lane = otid() & 63, gw = obid() * 8 + (otid() >> 6), ngw = gridDim.x * 8;
    for (int m = gw; m < M; m += ngw) ln_row(src + (size_t)m * D, dstf ? dstf + (size_t)m * D : nullptr, dstb ? dstb + (size_t)m * D : nullptr, g, b, lane);
}
__device__ __forceinline__ void convert_weights(const Params& p, int l, LAS float* scr, int gw, int ngw, int lane, int part) {
    constexpr int I_A = 64 * 16, I_B = 48 * 16, I_C = 8 * 16, I_O = 32 * 16, I_1 = 128 * 16, I_2 = 32 * 64;
    constexpr int PER_L = I_A + I_B + I_C + I_O + I_1 + I_2;
    const float* win = p.w_in + (size_t)l * D * 3600;
    bf16* winT = (bf16*)(p.ws + WS_WIN) + (size_t)l * NIN * D;
    const int lo = (part & 1) ? 0 : (I_A + I_B + I_C), hi = (part & 2) ? PER_L : (I_A + I_B + I_C);
    for (int it = lo + gw; it < hi; it += ngw) {
        int r = it;
        if (r < I_A) { tr_item(win, 3600, D, 0, 2048, winT, 0, scr, r / 64, r % 64, lane); continue; } r -= I_A;
        if (r < I_B) { tr_item(win, 3600, D, 2064, 1536, winT, 2048, scr, r / 48, r % 48, lane); continue; } r -= I_B;
        if (r < I_C) { tr_item(win, 3600, D, 2048, 16, winT, 3584, scr, r / 8, r % 8, lane); continue; } r -= I_C;
        if (r < I_O) { tr_item(p.w_out + (size_t)l * D * D, D, D, 0, D, (bf16*)(p.ws + WS_WOUT) + (size_t)l * D * D, 0, scr, r / 32, r % 32, lane); continue; } r -= I_O;
        if (r < I_1) { tr_item(p.w1 + (size_t)l * D * FF, FF, D, 0, FF, (bf16*)(p.ws + WS_W1) + (size_t)l * D * FF, 0, scr, r / 128, r % 128, lane); continue; } r -= I_1;
        tr_item(p.w2 + (size_t)l * D * FF, D, FF, 0, D, (bf16*)(p.ws + WS_W2) + (size_t)l * D * FF, 0, scr, r / 32, r % 32, lane);
    }
}
__device__ __forceinline__ void phase0(const Params& p, LAS unsigned char* lds) {
    const int lane = otid() & 63, w = otid() >> 6, gw = obid() * 8 + w, ngw = gridDim.x * 8;
    convert_weights(p, 0, (LAS float*)(lds + w * 16384), gw, ngw, lane, 1);
    ln_phase(p.x, nullptr, (bf16*)(p.ws + WS_XN), p.ln_in_g, p.ln_in_b);
}

__device__ __forceinline__ void prep_phase(const Params& p, int layer, LAS unsigned char* lds, int mode = 7) {
    const int tid = otid(), lane = tid & 63, w = tid >> 6;
    LAS bf16* Qs = (LAS bf16*)lds;
    LAS bf16* Ks = Qs + 64 * 136;
    LAS bf16* Vs = Ks + 64 * 136;
    LAS float* gcs = (LAS float*)(lds + 3 * 64 * 136 * 2);
    LAS float* bts = gcs + 128;
    const float* convw = p.conv_w + (size_t)layer * 5 * 1536;
    const bf16* HG = (const bf16*)(p.ws + WS_HG);
    const float* AB = (const float*)(p.ws + WS_AB);
    float* Amat = (float*)((unsigned char*)p.out + OUT_MIX);
    bf16* recq = (bf16*)(p.ws + WS_RQ); bf16* reck = (bf16*)(p.ws + WS_RK); bf16* recv = (bf16*)(p.ws + WS_RV);
    bf16* recti = (bf16*)(p.ws + WS_RTI); bf16* recqk = (bf16*)(p.ws + WS_RQK); float* recvec = (float*)(p.ws + WS_VEC);
    int nit = 0;
    for (int item = obid(); item < 2048; item += gridDim.x, ++nit) {
        if (!(mode & 5)) continue;
        const int b = item >> 9, h = (item >> 7) & 3, n = item & 127;
        const int m0 = b * T + 64 * n;
        if (mode & 1) {
        if (w < 2) {
            const int dir = w, r = lane, c = dir ? 63 - r : r, m = m0 + c;
            const float a = AB[(size_t)m * 16 + dir * 4 + h], bb = AB[(size_t)m * 16 + 8 + dir * 4 + h];
            const float Aa = expf(p.a_log[layer * 8 + dir * 4 + h]);
            const float xx = a + p.dt_bias[layer * 8 + dir * 4 + h];
            const float sp = xx > 20.f ? xx : log1pf(expf(xx));
            const float g = -Aa * sp, beta = 1.f / (1.f + expf(-bb));
            float gc = g;
#pragma unroll
            for (int o = 1; o < 64; o <<= 1) { const float t = __shfl_up(gc, o); if (lane >= o) gc += t; }
            const float gl = __shfl(gc, 63);
            gcs[dir * 64 + r] = gc; bts[dir * 64 + r] = beta;
            float* vec = recvec + (size_t)(item * 2 + dir) * 256;
            vec[r] = expf(gc); vec[64 + r] = beta; vec[128 + r] = expf(gl - gc); if (r == 0) vec[192] = expf(gl);
        }
#pragma unroll
        for (int s = 0; s < 3; ++s) {
            const int col = s * 512 + h * 128 + 2 * lane;
            float w0[5], w1[5];
#pragma unroll
            for (int i = 0; i < 5; ++i) { w0[i] = convw[i * 1536 + col]; w1[i] = convw[i * 1536 + col + 1]; }
            float x0[12], x1[12];
#pragma unroll
            for (int i = 0; i < 12; ++i) {
                const int tl = 64 * n + 8 * w - 2 + i;
                unsigned u = 0u;
                if (tl >= 0 && tl < T) u = *(const unsigned*)(HG + (size_t)(b * T + tl) * 1536 + col);
                x0[i] = bflo(u); x1[i] = bfhi(u);
            }
            LAS bf16* dst = (s == 0) ? Qs : (s == 1 ? Ks : Vs);
            const int pos = (s < 2) ? ppos(2 * lane) : 2 * lane;
#pragma unroll
            for (int c8 = 0; c8 < 8; ++c8) {
                float y0 = 0.f, y1 = 0.f;
#pragma unroll
                for (int i = 0; i < 5; ++i) { y0 += w0[i] * x0[c8 + i]; y1 += w1[i] * x1[c8 + i]; }
                y0 = y0 * __builtin_amdgcn_rcpf(1.f + __expf(-y0)); y1 = y1 * __builtin_amdgcn_rcpf(1.f + __expf(-y1));
                if (s < 2) {
                    const float ss = wave_sum(y0 * y0 + y1 * y1);
                    float inv = __builtin_amdgcn_rsqf(ss + 1e-6f);
                    if (s == 0) inv *= 0.08838834764831845f;
                    y0 *= inv; y1 *= inv;
                }
                *(LAS unsigned*)(dst + (8 * w + c8) * 136 + pos) = pk2(y0, y1);
            }
        }
        }
        LDS_BARRIER();
        if (mode & 4) {
        {
            bf16* qr = recq + (size_t)item * 8192; bf16* kr = reck + (size_t)item * 8192; bf16* vr = recv + (size_t)item * 8192;
            for (int ch = tid; ch < 1024; ch += 512) {
                const int r = ch >> 4, cc = ch & 15;
                *(u32x4*)(qr + r * 128 + cc * 8) = *(const LAS u32x4*)(Qs + r * 136 + cc * 8);
                *(u32x4*)(kr + r * 128 + cc * 8) = *(const LAS u32x4*)(Ks + r * 136 + cc * 8);
            }
            const int v = tid & 127;
            for (int cgp = tid >> 7; cgp < 8; cgp += 4) {
                const int c0 = 8 * cgp; unsigned short e[8];
#pragma unroll
                for (int k = 0; k < 8; ++k) e[k] = Vs[(c0 + k) * 136 + v];
                u32x4 o; o.x = e[0] | ((unsigned)e[1] << 16); o.y = e[2] | ((unsigned)e[3] << 16); o.z = e[4] | ((unsigned)e[5] << 16); o.w = e[6] | ((unsigned)e[7] << 16);
                *(u32x4*)(vr + v * 64 + c0) = o;
            }
        }
        {
            int lo_ = lane; asm volatile("" : "+v"(lo_));
            const int mat = w >> 2, ti = (w >> 1) & 1, tj = w & 1, l31 = lo_ & 31, h2 = lo_ >> 5;
            const LAS bf16* X = mat ? Qs : Ks;
            f32x16 acc;
#pragma unroll
            for (int r = 0; r < 16; ++r) acc[r] = 0.f;
#pragma unroll
            for (int s = 0; s < 8; ++s) {
                const bf16x8 a = *(const LAS bf16x8*)(Ks + (32 * tj + l31) * 136 + 16 * s + 8 * h2);
                const bf16x8 bb = *(const LAS bf16x8*)(X + (32 * ti + l31) * 136 + 16 * s + 8 * h2);
                acc = MFMA32(a, bb, acc);
            }
            const int i = 32 * ti + l31;
#pragma unroll
            for (int dir = 0; dir < 2; ++dir) {
                const int ri = dir ? 63 - i : i; const float gci = gcs[dir * 64 + ri], bti = bts[dir * 64 + ri];
                const size_t id = (size_t)(item * 2 + dir);
#pragma unroll
                for (int q = 0; q < 4; ++q) {
                    const int j0 = 32 * tj + 8 * q + 4 * h2;
                    const int rj0 = dir ? 60 - j0 : j0;
                    const f32x4 gq = *(const LAS f32x4*)(gcs + dir * 64 + rj0);
                    f32x4 val;
#pragma unroll
                    for (int e = 0; e < 4; ++e) {
                        const int rj = rj0 + e;
                        const float a = acc[4 * q + (dir ? 3 - e : e)];
                        const float ex = __expf(fminf(gci - gq[e], 0.f));
                        val[e] = (mat == 0) ? ((rj < ri) ? bti * a * ex : 0.f) : ((rj <= ri) ? a * ex : 0.f);
                    }
                    if (mat == 0) *(f32x4*)(Amat + id * 4096 + ri * 64 + rj0) = val;
                    else { u32x2 wv; wv.x = pk2(val[0], val[1]); wv.y = pk2(val[2], val[3]); *(u32x2*)(recqk + id * 4096 + ri * 64 + ppos(rj0)) = wv; }
                }
            }
        }
        }
        LDS_BARRIER();
    }
    __syncthreads();
    {

        for (int sidx = w; sidx < ((mode & 2) ? 2 * nit : 0); sidx += 8) {
            const int item = obid() + (sidx >> 1) * gridDim.x, dir = sidx & 1;
            const size_t id = (size_t)(item * 2 + dir);
            const float* Ag = Amat + id * 4096;
            float x[64];
            const float lanef = (float)lane;
            float rowv[8];
#pragma unroll
            for (int q = 0; q < 8; ++q) rowv[q] = Ag[q * 64 + lane];
#pragma unroll
            for (int i = 0; i < 64; ++i) {
                const float rv = rowv[i & 7];
                if (i + 8 < 64) rowv[i & 7] = Ag[(i + 8) * 64 + lane];
                float a0 = fmaxf(1.f - fabsf(lanef - (float)i), 0.f), a1 = 0.f, a2 = 0.f, a3 = 0.f;
#pragma unroll
                for (int j = 0; j < i; ++j) {
                    const float s = __builtin_bit_cast(float, __builtin_amdgcn_readlane(__builtin_bit_cast(int, rv), j));
                    if ((j & 3) == 0) a0 = fmaf(-s, x[j], a0); else if ((j & 3) == 1) a1 = fmaf(-s, x[j], a1); else if ((j & 3) == 2) a2 = fmaf(-s, x[j], a2); else a3 = fmaf(-s, x[j], a3);
                }
                x[i] = (a0 + a1) + (a2 + a3);
            }
            bf16* tr = recti + id * 4096; const int pos = ppos(lane);
#pragma unroll
            for (int i = 0; i < 64; ++i) tr[i * 64 + pos] = f2bf(x[i]);
        }
    }
}

constexpr int SC_BUF = 72704, SC_Q = 0, SC_K = 17408, SC_TI = 34816, SC_QK = 44032, SC_VEC = 53248, SC_V = 54272;
struct ScanRegs { u32x4 rq[4], rk[4], rt[2], rqk[2], rvv[4]; float rv; };
template <int dir> __device__ __forceinline__ void scan_fetch(const Params& p, int b, int h, int n, int lt, ScanRegs& R) {
    const int nt = dir ? 127 - n : n; const size_t item = (size_t)((b * 4 + h) * 128 + nt); const size_t id = item * 2 + dir;
    const bf16* qr = (const bf16*)(p.ws + WS_RQ) + item * 8192; const bf16* kr = (const bf16*)(p.ws + WS_RK) + item * 8192;
    const bf16* tr = (const bf16*)(p.ws + WS_RTI) + id * 4096; const bf16* qk = (const bf16*)(p.ws + WS_RQK) + id * 4096;
    const float* vec = (const float*)(p.ws + WS_VEC) + id * 256;
    const bf16* vt = (const bf16*)(p.ws + WS_RV) + item * 8192;
#pragma unroll
    for (int i = 0; i < 4; ++i) { const int ch = lt + 256 * i; R.rvv[i] = *(const u32x4*)(vt + ch * 8); }
#pragma unroll
    for (int i = 0; i < 4; ++i) { const int ch = lt + 256 * i, r = ch >> 4, cc = ch & 15, sr = dir ? 63 - r : r; R.rq[i] = *(const u32x4*)(qr + sr * 128 + cc * 8); R.rk[i] = *(const u32x4*)(kr + sr * 128 + cc * 8); }
#pragma unroll
    for (int i = 0; i < 2; ++i) { const int ch = lt + 256 * i, r = ch >> 3, cc = ch & 7; R.rt[i] = *(const u32x4*)(tr + r * 64 + cc * 8); R.rqk[i] = *(const u32x4*)(qk + r * 64 + cc * 8); }
    R.rv = (lt < 193) ? vec[lt] : 0.f;
}
__device__ __forceinline__ void scan_store(LAS unsigned char* buf, int lt, const ScanRegs& R) {
#pragma unroll
    for (int i = 0; i < 4; ++i) { const int ch = lt + 256 * i, r = ch >> 4, cc = ch & 15; *(LAS u32x4*)(buf + SC_Q + (r * 136 + cc * 8) * 2) = R.rq[i]; *(LAS u32x4*)(buf + SC_K + (r * 136 + cc * 8) * 2) = R.rk[i]; }
#pragma unroll
    for (int i = 0; i < 2; ++i) { const int ch = lt + 256 * i, r = ch >> 3, cc = ch & 7; *(LAS u32x4*)(buf + SC_TI + (r * 72 + cc * 8) * 2) = R.rt[i]; *(LAS u32x4*)(buf + SC_QK + (r * 72 + cc * 8) * 2) = R.rqk[i]; }
    *(LAS float*)(buf + SC_VEC + lt * 4) = R.rv;
#pragma unroll
    for (int i = 0; i < 4; ++i) { const int ch = lt + 256 * i, v = ch >> 3, cc = ch & 7; *(LAS u32x4*)(buf + SC_V + v * 144 + cc * 16) = R.rvv[i]; }
}
template <int dir, int smode = 7> __device__ __forceinline__ void scan_chain(const Params& p, int layer, LAS unsigned char* lds, int chain) {
    const int tid = otid(), lane = tid & 63, w = __builtin_amdgcn_readfirstlane(tid >> 6);
    const int half = (chain >> 3) & 1; chain = ((chain >> 4) << 3) | (chain & 7);
    const int b = chain >> 3, h = (chain >> 1) & 3;
    const int l31 = lane & 31, h2 = lane >> 5, vcol = 64 * half + 32 * (w & 1) + l31;
    bf16* og = (bf16*)(p.ws + WS_HG) + (size_t)dir * M * 512;
    if (w >= 4) {
        if (!(smode & 1)) { LDS_BARRIER(); for (int n = 0; n < 128; ++n) LDS_BARRIER(); return; }
        ScanRegs R0, R1;
        scan_fetch<dir>(p, b, h, 0, tid - 256, R0); scan_store(lds, tid - 256, R0); scan_fetch<dir>(p, b, h, 1, tid - 256, R0); scan_fetch<dir>(p, b, h, 2, tid - 256, R1);
        LDS_BARRIER();
#pragma unroll 1
        for (int n = 0; n < 128; n += 2) {
            scan_store(lds + SC_BUF, tid - 256, R0);
            if (n + 3 < 128) scan_fetch<dir>(p, b, h, n + 3, tid - 256, R0);
            LDS_BARRIER();
            if (n + 2 < 128) scan_store(lds, tid - 256, R1);
            if (n + 4 < 128) scan_fetch<dir>(p, b, h, n + 4, tid - 256, R1);
            LDS_BARRIER();
        }
    } else if (w >= 2) {
        LDS_BARRIER();
#pragma unroll 1
        for (int n = 0; n < 128; ++n) LDS_BARRIER();
    } else {
        if (!(smode & 2)) { LDS_BARRIER(); for (int n = 0; n < 128; ++n) LDS_BARRIER(); return; }
        f32x16 S[4];
#pragma unroll
        for (int k = 0; k < 4; ++k)
#pragma unroll
            for (int r = 0; r < 16; ++r) S[k][r] = 0.f;
        LDS_BARRIER();
#pragma unroll 1
        for (int n = 0; n < 128; ++n) {
            const LAS unsigned char* buf = lds + (n & 1) * SC_BUF;
            const LAS bf16* Qp = (const LAS bf16*)(buf + SC_Q); const LAS bf16* Kp = (const LAS bf16*)(buf + SC_K);
            const LAS bf16* Ti = (const LAS bf16*)(buf + SC_TI); const LAS bf16* QKm = (const LAS bf16*)(buf + SC_QK);
            const LAS float* vecl = (const LAS float*)(buf + SC_VEC);
            const float gl = vecl[192];
            bf16x8 Sb[8];
#pragma unroll
            for (int kt = 0; kt < 4; ++kt)
#pragma unroll
                for (int s = 0; s < 2; ++s) Sb[2 * kt + s] = pack8(S[kt][8 * s + 0], S[kt][8 * s + 1], S[kt][8 * s + 2], S[kt][8 * s + 3], S[kt][8 * s + 4], S[kt][8 * s + 5], S[kt][8 * s + 6], S[kt][8 * s + 7]);
            SBAR;
            f32x16 kA, kB;
#pragma unroll
            for (int r = 0; r < 16; ++r) { kA[r] = 0.f; kB[r] = 0.f; }
#pragma unroll
            for (int hf = 0; hf < 2; ++hf) {
                bf16x8 f0[4], f1[4];
#pragma unroll
                for (int k4 = 0; k4 < 4; ++k4) {
                    f0[k4] = *(const LAS bf16x8*)(Kp + (l31) * 136 + 16 * (4 * hf + k4) + 8 * h2);
                    f1[k4] = *(const LAS bf16x8*)(Kp + (32 + l31) * 136 + 16 * (4 * hf + k4) + 8 * h2);
                }
                SBAR;
#pragma unroll
                for (int k4 = 0; k4 < 4; ++k4) { kA = MFMA32(f0[k4], Sb[4 * hf + k4], kA); kB = MFMA32(f1[k4], Sb[4 * hf + k4], kB); }
                SBAR;
            }
            f32x16 qA, qB;
#pragma unroll
            for (int r = 0; r < 16; ++r) { qA[r] = 0.f; qB[r] = 0.f; }
            bf16x8 tb[4];
#pragma unroll
            for (int pt = 0; pt < 4; ++pt) {
                const int mt = pt >> 1, s = pt & 1;
                bf16x8 f0[2], f1[2];
#pragma unroll
                for (int k2 = 0; k2 < 2; ++k2) {
                    f0[k2] = *(const LAS bf16x8*)(Qp + (l31) * 136 + 16 * (2 * pt + k2) + 8 * h2);
                    f1[k2] = *(const LAS bf16x8*)(Qp + (32 + l31) * 136 + 16 * (2 * pt + k2) + 8 * h2);
                }
                f32x4 eg[2], bt[2]; u32x2 vq[2];
#pragma unroll
                for (int qq = 0; qq < 2; ++qq) {
                    const int q = 2 * s + qq;
                    eg[qq] = *(const LAS f32x4*)(vecl + 32 * mt + 8 * q + 4 * h2); bt[qq] = *(const LAS f32x4*)(vecl + 64 + 32 * mt + 8 * q + 4 * h2);
                    vq[qq] = *(const LAS u32x2*)(buf + SC_V + vcol * 144 + (dir ? 60 - (32 * mt + 8 * q + 4 * h2) : (32 * mt + 8 * q + 4 * h2)) * 2);
                }
                SBAR;
#pragma unroll
                for (int k2 = 0; k2 < 2; ++k2) { qA = MFMA32(f0[k2], Sb[2 * pt + k2], qA); qB = MFMA32(f1[k2], Sb[2 * pt + k2], qB); }
                float t8[8];
#pragma unroll
                for (int qq = 0; qq < 2; ++qq) {
                    const u32x2 u = vq[qq];
                    const float e0 = bflo(u.x), e1 = bfhi(u.x), e2 = bflo(u.y), e3 = bfhi(u.y);
                    f32x4 vv; vv[0] = dir ? e3 : e0; vv[1] = dir ? e2 : e1; vv[2] = dir ? e1 : e2; vv[3] = dir ? e0 : e3;
#pragma unroll
                    for (int e = 0; e < 4; ++e) { const float ksv = mt ? kB[8 * s + 4 * qq + e] : kA[8 * s + 4 * qq + e]; t8[4 * qq + e] = bt[qq][e] * (vv[e] - eg[qq][e] * ksv); }
                }
                tb[pt] = pack8(t8[0], t8[1], t8[2], t8[3], t8[4], t8[5], t8[6], t8[7]);
#pragma unroll
                for (int g = 0; g < 4; ++g) { __builtin_amdgcn_sched_group_barrier(0x8, 1, 0); __builtin_amdgcn_sched_group_barrier(0x2, 9, 0); }
                SBAR;
            }
            f32x16 vA, vB;
#pragma unroll
            for (int r = 0; r < 16; ++r) { vA[r] = 0.f; vB[r] = 0.f; }
            {
                bf16x8 f0[4], f1[4];
#pragma unroll
                for (int ks = 0; ks < 4; ++ks) {
                    f0[ks] = *(const LAS bf16x8*)(Ti + (l31) * 72 + 16 * ks + 8 * h2);
                    f1[ks] = *(const LAS bf16x8*)(Ti + (32 + l31) * 72 + 16 * ks + 8 * h2);
                }
                f32x4 egA[4], egB[4];
#pragma unroll
                for (int q = 0; q < 4; ++q) { egA[q] = *(const LAS f32x4*)(vecl + 8 * q + 4 * h2); egB[q] = *(const LAS f32x4*)(vecl + 32 + 8 * q + 4 * h2); }
                SBAR;
#pragma unroll
                for (int ks = 0; ks < 4; ++ks) { vA = MFMA32(f0[ks], tb[ks], vA); vB = MFMA32(f1[ks], tb[ks], vB); }
#pragma unroll
                for (int q = 0; q < 4; ++q)
#pragma unroll
                    for (int e = 0; e < 4; ++e) { qA[4 * q + e] *= egA[q][e]; qB[4 * q + e] *= egB[q][e]; }
#pragma unroll
                for (int kt = 0; kt < 4; ++kt)
#pragma unroll
                    for (int r = 0; r < 16; ++r) S[kt][r] *= gl;
#pragma unroll
                for (int g = 0; g < 8; ++g) { __builtin_amdgcn_sched_group_barrier(0x8, 1, 0); __builtin_amdgcn_sched_group_barrier(0x2, 6, 0); }
                SBAR;
            }
            bf16x8 vb[4], vsb[4];
            {
                f32x4 ekA[4], ekB[4];
#pragma unroll
                for (int q = 0; q < 4; ++q) { ekA[q] = *(const LAS f32x4*)(vecl + 128 + 8 * q + 4 * h2); ekB[q] = *(const LAS f32x4*)(vecl + 128 + 32 + 8 * q + 4 * h2); }
#pragma unroll
                for (int s = 0; s < 2; ++s) {
                    vb[s] = pack8(vA[8 * s + 0], vA[8 * s + 1], vA[8 * s + 2], vA[8 * s + 3], vA[8 * s + 4], vA[8 * s + 5], vA[8 * s + 6], vA[8 * s + 7]);
                    vb[2 + s] = pack8(vB[8 * s + 0], vB[8 * s + 1], vB[8 * s + 2], vB[8 * s + 3], vB[8 * s + 4], vB[8 * s + 5], vB[8 * s + 6], vB[8 * s + 7]);
                    vsb[s] = pack8(ekA[2 * s][0] * vA[8 * s + 0], ekA[2 * s][1] * vA[8 * s + 1], ekA[2 * s][2] * vA[8 * s + 2], ekA[2 * s][3] * vA[8 * s + 3], ekA[2 * s + 1][0] * vA[8 * s + 4], ekA[2 * s + 1][1] * vA[8 * s + 5], ekA[2 * s + 1][2] * vA[8 * s + 6], ekA[2 * s + 1][3] * vA[8 * s + 7]);
                    vsb[2 + s] = pack8(ekB[2 * s][0] * vB[8 * s + 0], ekB[2 * s][1] * vB[8 * s + 1], ekB[2 * s][2] * vB[8 * s + 2], ekB[2 * s][3] * vB[8 * s + 3], ekB[2 * s + 1][0] * vB[8 * s + 4], ekB[2 * s + 1][1] * vB[8 * s + 5], ekB[2 * s + 1][2] * vB[8 * s + 6], ekB[2 * s + 1][3] * vB[8 * s + 7]);
                }
            }
            SBAR;
            {
                const int g4 = lane >> 4, i16 = lane & 15, q4 = i16 >> 2, pp = i16 & 3, pq = ((pp & 1) << 1) | (pp >> 1);
                const LAS bf16* kb0 = Kp + (4 * h2 + q4) * 136 + 16 * (g4 & 1) + 4 * pq;
                const int nt = dir ? 127 - n : n;
                bf16* ob = og + (size_t)(b * T + 64 * nt) * 512 + h * 128 + vcol;
                s16x4 lo0[4], hi0[4], lo1[4], hi1[4];
#pragma unroll
                for (int ks = 0; ks < 4; ++ks) {
                    lo0[ks] = trread(kb0 + (16 * ks) * 136); hi0[ks] = trread(kb0 + (16 * ks + 8) * 136);
                    lo1[ks] = trread(kb0 + (16 * ks) * 136 + 32); hi1[ks] = trread(kb0 + (16 * ks + 8) * 136 + 32);
                }
                bf16x8 f0[4], f1[4];
#pragma unroll
                for (int ks = 0; ks < 4; ++ks) {
                    f0[ks] = *(const LAS bf16x8*)(QKm + (l31) * 72 + 16 * ks + 8 * h2);
                    f1[ks] = *(const LAS bf16x8*)(QKm + (32 + l31) * 72 + 16 * ks + 8 * h2);
                }
                SBAR;
#pragma unroll
                for (int ks = 0; ks < 4; ++ks) {
                    S[0] = MFMA32(cat8(lo0[ks], hi0[ks]), vsb[ks], S[0]);
                    S[1] = MFMA32(cat8(lo1[ks], hi1[ks]), vsb[ks], S[1]);
                }
#pragma unroll
                for (int ks = 0; ks < 4; ++ks) { qA = MFMA32(f0[ks], vb[ks], qA); qB = MFMA32(f1[ks], vb[ks], qB); }
                SBAR;
#pragma unroll
                for (int ks = 0; ks < 4; ++ks) {
                    lo0[ks] = trread(kb0 + (16 * ks) * 136 + 64); hi0[ks] = trread(kb0 + (16 * ks + 8) * 136 + 64);
                    lo1[ks] = trread(kb0 + (16 * ks) * 136 + 96); hi1[ks] = trread(kb0 + (16 * ks + 8) * 136 + 96);
                }
                SBAR;
#pragma unroll
                for (int ks = 0; ks < 4; ++ks) {
                    S[2] = MFMA32(cat8(lo0[ks], hi0[ks]), vsb[ks], S[2]);
                    S[3] = MFMA32(cat8(lo1[ks], hi1[ks]), vsb[ks], S[3]);
                }
                const int odd = lane & 1;
                bf16* obo = ob + (odd ? (dir ? -512 : 512) - 1 : 0);
#pragma unroll
                for (int mt = 0; mt < 2; ++mt)
#pragma unroll
                    for (int q = 0; q < 4; ++q)
#pragma unroll
                        for (int ep = 0; ep < 2; ++ep) {
                            const float x = mt ? qB[4 * q + 2 * ep] : qA[4 * q + 2 * ep], y = mt ? qB[4 * q + 2 * ep + 1] : qA[4 * q + 2 * ep + 1];
                            const float snd = odd ? x : y;
                            const float rcv = __builtin_bit_cast(float, __builtin_amdgcn_mov_dpp(__builtin_bit_cast(int, snd), 0xB1, 0xF, 0xF, true));
                            const unsigned pk = odd ? pk2(rcv, y) : pk2(x, rcv);
                            const int r = 32 * mt + 8 * q + 4 * h2 + 2 * ep; const int c = dir ? 63 - r : r;
                            if (smode & 4) *(unsigned*)(obo + (ptrdiff_t)c * 512) = pk;
                        }
                SBAR;
            }
            LDS_BARRIER();
        }
    }
}

__device__ __forceinline__ void na_items(const Params& p, int layer, LAS unsigned char* lds, int widx, int wstride) {
    const int lane = otid() & 63, w = otid() >> 6;
    const int fr = lane & 15, fq = lane >> 4;
    const LAS float* rp = (const LAS float*)lds;
    LAS bf16* Vst = (LAS bf16*)(lds + 16384 + w * 5120);
    const bf16* HN = (const bf16*)(p.ws + WS_HN);
    bf16* MIX = (bf16*)((unsigned char*)p.out + OUT_MIX);
    const float* ng = p.na_norm_g + layer * 64;
    for (int it = widx; it < 16384; it += wstride) {
        const int hh = it & 7, j = (it >> 3) & 3, r = (it >> 5) & 127, b = it >> 12;
        int r0 = r - 4; r0 = r0 < 0 ? 0 : (r0 > 120 ? 120 : r0);
        int ss = 16 * j - 8; ss = ss < 0 ? 0 : (ss > 32 ? 32 : ss);
        const int qc = 16 * j + fr;
        int wsn = qc - 8; wsn = wsn < 0 ? 0 : (wsn > 48 ? 48 : wsn);
        const size_t mq = (size_t)b * T + r * 64 + qc;
        bf16x8 Qf[2];
#pragma unroll
        for (int ks = 0; ks < 2; ++ks) Qf[ks] = *(const bf16x8*)(HN + mq * 1536 + hh * 64 + 32 * ks + 8 * fq);
        u32x4 vr[4][4];
#pragma unroll
        for (int i = 0; i < 4; ++i)
#pragma unroll
            for (int m4 = 0; m4 < 4; ++m4) {
                const int idx = lane + 64 * m4, key = idx >> 3, chn = idx & 7;
                const size_t mk = (size_t)b * T + (r0 + i) * 64 + ss + key;
                vr[i][m4] = *(const u32x4*)(HN + mk * 1536 + 1024 + hh * 64 + 8 * chn);
            }
        f32x4 sc[8][2];
#pragma unroll
        for (int i = 0; i < 8; ++i)
#pragma unroll
            for (int t = 0; t < 2; ++t) {
                const size_t mk = (size_t)b * T + (r0 + i) * 64 + ss + 16 * t + fr;
                const bf16x8 k0 = *(const bf16x8*)(HN + mk * 1536 + 512 + hh * 64 + 8 * fq);
                const bf16x8 k1 = *(const bf16x8*)(HN + mk * 1536 + 512 + hh * 64 + 32 + 8 * fq);
                f32x4 a = {0.f, 0.f, 0.f, 0.f};
                a = MFMA16(k0, Qf[0], a); a = MFMA16(k1, Qf[1], a);
                sc[i][t] = a;
            }
        float mx = -INFINITY;
#pragma unroll
        for (int i = 0; i < 8; ++i) {
            const int dr = r0 + i - r + 7;
            const LAS float* rb = rp + (hh * 15 + dr) * 31;
#pragma unroll
            for (int t = 0; t < 2; ++t)
#pragma unroll
                for (int e = 0; e < 4; ++e) {
                    const int kc = ss + 16 * t + 4 * fq + e;
                    int rel = kc - qc + 15; rel = rel < 0 ? 0 : (rel > 30 ? 30 : rel);
                    const bool valid = (kc >= wsn) && (kc < wsn + 16);
                    const float s = valid ? (sc[i][t][e] * 0.125f + rb[rel]) : -INFINITY;
                    sc[i][t][e] = s; mx = fmaxf(mx, s);
                }
        }
        mx = fmaxf(mx, __shfl_xor(mx, 16)); mx = fmaxf(mx, __shfl_xor(mx, 32));
        float sum = 0.f;
#pragma unroll
        for (int i = 0; i < 8; ++i)
#pragma unroll
            for (int t = 0; t < 2; ++t)
#pragma unroll
                for (int e = 0; e < 4; ++e) { const float pe = __expf(sc[i][t][e] - mx); sc[i][t][e] = pe; sum += pe; }
        sum += __shfl_xor(sum, 16); sum += __shfl_xor(sum, 32);
        f32x4 O[4];
#pragma unroll
        for (int dt = 0; dt < 4; ++dt) O[dt] = (f32x4){0.f, 0.f, 0.f, 0.f};
#pragma unroll
        for (int i = 0; i < 8; ++i) {
            WAVE_SYNC();
#pragma unroll
            for (int m4 = 0; m4 < 4; ++m4) { const int idx = lane + 64 * m4, key = idx >> 3, chn = idx & 7; *(LAS u32x4*)(Vst + key * 80 + chn * 8) = vr[i & 3][m4]; }
            if (i + 4 < 8) {
#pragma unroll
                for (int m4 = 0; m4 < 4; ++m4) {
                    const int idx = lane + 64 * m4, key = idx >> 3, chn = idx & 7;
                    const size_t mk = (size_t)b * T + (r0 + i + 4) * 64 + ss + key;
                    vr[i & 3][m4] = *(const u32x4*)(HN + mk * 1536 + 1024 + hh * 64 + 8 * chn);
                }
            }
            WAVE_SYNC();
            const f32x4 p0 = sc[i][0], p1 = sc[i][1];
            const bf16x8 Pf = pack8(p0[0], p0[1], p0[2], p0[3], p1[0], p1[1], p1[2], p1[3]);
            const int q4 = fr >> 2, pp = fr & 3;
#pragma unroll
            for (int dt = 0; dt < 4; ++dt) {
                const s16x4 lo = trread(Vst + (4 * fq + q4) * 80 + 16 * dt + 4 * pp);
                const s16x4 hi = trread(Vst + (16 + 4 * fq + q4) * 80 + 16 * dt + 4 * pp);
                O[dt] = MFMA16(Pf, cat8(lo, hi), O[dt]);
            }
        }
#pragma unroll
        for (int e = 0; e < 4; ++e) {
            const float sm = __shfl(sum, 4 * fq + e);
            const float inv = 1.0f / sm;
            float o0 = O[0][e] * inv, o1 = O[1][e] * inv, o2 = O[2][e] * inv, o3 = O[3][e] * inv;
            float ssq = o0 * o0 + o1 * o1 + o2 * o2 + o3 * o3;
            ssq += __shfl_xor(ssq, 1); ssq += __shfl_xor(ssq, 2); ssq += __shfl_xor(ssq, 4); ssq += __shfl_xor(ssq, 8);
            const float rs = 1.0f / sqrtf(ssq * (1.f / 64.f) + 1e-6f);
            const size_t mo = (size_t)b * T + r * 64 + 16 * j + 4 * fq + e;
            bf16* dst = MIX + mo * 1024 + 512 + hh * 64 + fr;
            dst[0] = f2bf(o0 * rs * ng[fr]); dst[16] = f2bf(o1 * rs * ng[16 + fr]); dst[32] = f2bf(o2 * rs * ng[32 + fr]); dst[48] = f2bf(o3 * rs * ng[48 + fr]);
        }
    }
}
template <int smode = 7> __device__ __forceinline__ void scan_na_phase(const Params& p, int layer, LAS unsigned char* lds, int mode = 3) {
    if (obid() < NSCAN) {
#if !defined(MK_NO_SCAN)
        if (!(mode & 1)) {} else if (obid() & 1) scan_chain<1, smode>(p, layer, lds, obid()); else scan_chain<0, smode>(p, layer, lds, obid());
#endif
    }
    else {
        const float* rpb = p.rpb + (size_t)layer * 8 * 15 * 31;
        for (int i = otid(); i < 8 * 15 * 31; i += 512) ((LAS float*)lds)[i] = rpb[i];
        __syncthreads();
#if !defined(MK_NO_NA)
        if (mode & 2) na_items(p, layer, lds, (obid() - NSCAN) * 8 + (otid() >> 6), ((int)gridDim.x - NSCAN) * 8);
        if ((mode & 2) && layer == 0 && smode == 7) {
            LAS float* scr = (LAS float*)(lds + 65536 + (otid() >> 6) * 8704); const int gw = (obid() - NSCAN) * 8 + (otid() >> 6), ngw = ((int)gridDim.x - NSCAN) * 8;
            convert_weights(p, 0, scr, gw, ngw, otid() & 63, 2);
            convert_weights(p, 1, scr, gw, ngw, otid() & 63, 3);
        }
#endif
    }
}

__device__ __forceinline__ void combine_phase(const Params& p, int layer) {
    const int lane = otid() & 63, gw = obid() * 8 + (otid() >> 6), ngw = gridDim.x * 8;
    const bf16* og = (const bf16*)(p.ws + WS_HG); const bf16* HZ = (const bf16*)(p.ws + WS_HZ); bf16* MIX = (bf16*)((unsigned char*)p.out + OUT_MIX);
    const float* g = p.gdn_norm_g + layer * 128;
    const int col = 8 * lane;
    float gv[8];
#pragma unroll
    for (int k = 0; k < 8; ++k) gv[k] = g[(col & 127) + k];
    for (int m = gw; m < M; m += ngw) {
        const u32x4 a = *(const u32x4*)(og + (size_t)m * 512 + col), bq = *(const u32x4*)(og + (size_t)M * 512 + (size_t)m * 512 + col), z = *(const u32x4*)(HZ + (size_t)m * 512 + col);
        float o[8], zz[8];
#pragma unroll
        for (int k = 0; k < 4; ++k) { o[2 * k] = bflo(a[k]) + bflo(bq[k]); o[2 * k + 1] = bfhi(a[k]) + bfhi(bq[k]); zz[2 * k] = bflo(z[k]); zz[2 * k + 1] = bfhi(z[k]); }
        float ssq = 0.f;
#pragma unroll
        for (int k = 0; k < 8; ++k) ssq += o[k] * o[k];
        ssq += __shfl_xor(ssq, 1); ssq += __shfl_xor(ssq, 2); ssq += __shfl_xor(ssq, 4); ssq += __shfl_xor(ssq, 8);
        const float rs = 1.0f / sqrtf(ssq * (1.f / 128.f) + 1e-6f);
        float y[8];
#pragma unroll
        for (int k = 0; k < 8; ++k) { const float sz = zz[k] * __builtin_amdgcn_rcpf(1.f + __expf(-zz[k])); y[k] = o[k] * rs * gv[k] * sz; }
        u32x4 wv; wv.x = pk2(y[0], y[1]); wv.y = pk2(y[2], y[3]); wv.z = pk2(y[4], y[5]); wv.w = pk2(y[6], y[7]);
        *(u32x4*)(MIX + (size_t)m * 1024 + col) = wv;
    }
}

#define XB_TMO      128
#define XB_XCNT(j)  (256  + 64 * (j))
#define XB_XSUB(j)  (1280 + 64 * (j))
#define XB_XGEN(j)  (2304 + 64 * (j))
#define XB_TOP      3328
#define XB_TOPGEN   3392
#define XCD_BAR_WORDS 3456
#define XB_SPIN_CAP (1u << 18)

__device__ __forceinline__ unsigned xb_ld(unsigned* p)              { return __hip_atomic_load(p, __ATOMIC_RELAXED, __HIP_MEMORY_SCOPE_AGENT); }
__device__ __forceinline__ unsigned xb_add(unsigned* p, unsigned v) { return __hip_atomic_fetch_add(p, v, __ATOMIC_RELAXED, __HIP_MEMORY_SCOPE_AGENT); }
__device__ __forceinline__ unsigned xb_xcc_id() { return (unsigned)__builtin_amdgcn_s_getreg((3 << 11) | 20) & 0xFu; }
#define XB_SPIN(cond, bar) do { unsigned _sp = 0; while (cond) { __builtin_amdgcn_s_sleep(1); \
    if ((++_sp & 255u) == 0u) { if (xb_ld(&(bar)[XB_TMO])) break; if (_sp > XB_SPIN_CAP) { atomicAdd(&(bar)[XB_TMO], 1u); break; } } } } while (0)

struct XcdBarrier {
    unsigned* bar; unsigned x;
    volatile LAS unsigned* st;
};

__device__ __forceinline__ XcdBarrier xcd_barrier_post(unsigned* bar, volatile LAS unsigned* st) {
    XcdBarrier b; b.bar = bar; b.x = xb_xcc_id(); b.st = st;
    if (threadIdx.x == 0) (void)xb_add(&bar[XB_XCNT(b.x)], 1u);
    return b;
}
__device__ __forceinline__ void xcd_barrier_complete(unsigned* bar, unsigned x, unsigned& nloc, unsigned& nx) {
    const unsigned G = gridDim.x * gridDim.y * gridDim.z;
    unsigned sum, cnt, mine, sp = 0u;
    for (;;) {
        sum = 0u; cnt = 0u; mine = 0u;
#pragma unroll
        for (unsigned j = 0; j < 16; ++j) { const unsigned c = xb_ld(&bar[XB_XCNT(j)]); sum += c; cnt += (c > 0u) ? 1u : 0u; mine = (j == x) ? c : mine; }
        if (sum == G) break;
        __builtin_amdgcn_s_sleep(1);
        if ((++sp & 255u) == 0u) { if (xb_ld(&bar[XB_TMO])) break; if (sp > XB_SPIN_CAP) { atomicAdd(&bar[XB_TMO], 1u); break; } }
    }
    nloc = mine > 0u ? mine : 1u; nx = cnt > 0u ? cnt : 1u;
}

__device__ __forceinline__ void xcd_barrier(const XcdBarrier& b) {
    asm volatile("s_waitcnt vmcnt(0)" ::: "memory");
    __syncthreads();
    if (threadIdx.x == 0) {
        unsigned* bar = b.bar;
        __builtin_amdgcn_s_waitcnt(0);
        unsigned nloc = b.st[0], nx = b.st[1];
        if (nloc == 0u) { xcd_barrier_complete(bar, b.x, nloc, nx); b.st[0] = nloc; b.st[1] = nx; }
        const unsigned old = xb_add(&bar[XB_XSUB(b.x)], 1u);
        const unsigned gen = old / nloc;
        if (old + 1u == (gen + 1u) * nloc) {
            __builtin_amdgcn_fence(__ATOMIC_RELEASE, "agent");
            asm volatile("s_waitcnt vmcnt(0)" ::: "memory");
            const unsigned og = xb_add(&bar[XB_TOP], 1u);
            const unsigned tg = og / nx;
            if (og + 1u == (tg + 1u) * nx) xb_add(&bar[XB_TOPGEN], 1u);
            else XB_SPIN(xb_ld(&bar[XB_TOPGEN]) == tg, bar);
            __builtin_amdgcn_fence(__ATOMIC_ACQUIRE, "agent");
            xb_add(&bar[XB_XGEN(b.x)], 1u);
            asm volatile("s_waitcnt vmcnt(0)" ::: "memory");
        } else {
            XB_SPIN(xb_ld(&bar[XB_XGEN(b.x)]) == gen, bar);
            __builtin_amdgcn_fence(__ATOMIC_ACQUIRE, "agent");
            asm volatile("s_waitcnt vmcnt(0)" ::: "memory");
        }
    }
    __syncthreads();
}

typedef const __attribute__((address_space(4))) Params* KParamsPtr;
__device__ __forceinline__ Params load_params() {
#if defined(__HIP_DEVICE_COMPILE__)
    KParamsPtr kp = (KParamsPtr)__builtin_amdgcn_kernarg_segment_ptr(); asm volatile("" : "+s"(kp)); return *kp;
#else
    return Params{};
#endif
}
#if defined(MK_CG_SYNC)
#define GSYNC() grid.sync()
#else
#define GSYNC() xcd_barrier(xbar)
#endif
__global__ void __launch_bounds__(512, 2) mega_fwd(Params p_unused) {
    extern __shared__ __attribute__((aligned(16))) unsigned char lds_raw[];
    cg::grid_group grid = cg::this_grid();
    LAS unsigned char* lds = (LAS unsigned char*)lds_raw;
    volatile LAS unsigned* bst = (volatile LAS unsigned*)(lds + LDS_BYTES - 16);
    if (threadIdx.x == 0) { bst[0] = 0u; bst[1] = 0u; }
    __syncthreads();
    XcdBarrier xbar;
    { const Params p = load_params(); xbar = xcd_barrier_post((unsigned*)p.ws, bst); }
#if defined(MK_DUP_P0)
    { const Params p = load_params(); phase0(p, lds); }
    GSYNC();
#endif
    { const Params p = load_params(); phase0(p, lds); }
    GSYNC();
#if defined(MK_EXTRA_SYNCS)
    for (int i = 0; i < MK_EXTRA_SYNCS; ++i) GSYNC();
#endif
#pragma unroll 1
    for (int l = 0; l < 2; ++l) {
        {
            const Params p = load_params(); const int G = gridDim.x, c = obid();
            pg8::Gemm g{(const bf16*)(p.ws + WS_XN), (const bf16*)(p.ws + WS_WIN) + (size_t)l * NIN * D, M, NIN, D}; pg8::StaticOrder S; S.init(M, NIN, G, c);
            EpiIn E{(bf16*)(p.ws + WS_HG), (bf16*)(p.ws + WS_HZ), (bf16*)(p.ws + WS_HN), (float*)(p.ws + WS_AB)};
            pg8::gemm_phase<EpiIn, pg8::StaticOrder, true, true>(lds, g, S, E);
#if defined(MK_DUP_GIN)
            GSYNC();
            pg8::gemm_phase<EpiIn, pg8::StaticOrder, true, true>(lds, g, S, E);
#endif
        }
        GSYNC();
#if !defined(MK_SKIP_MIXER)
#if defined(MK_DUP_PREP_PRE)
        { const Params p = load_params(); prep_phase(p, l, lds, MK_DUP_PREP_PRE); }
        GSYNC();
#endif
#if !defined(MK_SKIP_PREP)
        { const Params p = load_params(); prep_phase(p, l, lds); }
        GSYNC();
#endif
#if defined(MK_DUP_PREP)
        { const Params p = load_params(); prep_phase(p, l, lds, MK_DUP_PREP); }
        GSYNC();
#endif
#if !defined(MK_SKIP_SCAN)
        { const Params p = load_params(); scan_na_phase(p, l, lds); }
        if (l == 0) grid.sync(); else GSYNC();
#endif
#if defined(MK_DUP_SCAN)
        { const Params p = load_params(); scan_na_phase<MK_DUP_SCAN>(p, l, lds, 1); }
        GSYNC();
#endif
#if defined(MK_DUP_NA)
        { const Params p = load_params(); scan_na_phase(p, l, lds, 2); }
        GSYNC();
#endif
        { const Params p = load_params(); combine_phase(p, l); }
        GSYNC();
#endif
        {
            const Params p = load_params(); const int G = gridDim.x, c = obid();
            pg8::Gemm g{(const bf16*)((unsigned char*)p.out + OUT_MIX), (const bf16*)(p.ws + WS_WOUT) + (size_t)l * D * D, M, D, D}; pg8::StaticOrder S; S.init(M, D, G, c);
            EpiRes E{(const bf16*)(p.ws + WS_XN), (bf16*)(p.ws + WS_YB), nullptr};
            pg8::gemm_phase<EpiRes, pg8::StaticOrder, true, true>(lds, g, S, E);
        }
        GSYNC();
        { const Params p = load_params(); ln_phase_b((const bf16*)(p.ws + WS_YB), nullptr, (bf16*)(p.ws + WS_XN), p.ln1_g + l * D, p.ln1_b + l * D); }
        GSYNC();
        {
            const Params p = load_params(); const int G = gridDim.x, c = obid();
            pg8::Gemm g{(const bf16*)(p.ws + WS_XN), (const bf16*)(p.ws + WS_W1) + (size_t)l * D * FF, M, FF, D}; pg8::StaticOrder S; S.init(M, FF, G, c);
            EpiUp E{(bf16*)(p.ws + WS_HB), p.b1 + l * FF};
            pg8::gemm_phase<EpiUp, pg8::StaticOrder, true, true>(lds, g, S, E);
#if defined(MK_DUP_GUP)
            GSYNC();
            pg8::gemm_phase<EpiUp, pg8::StaticOrder, true, true>(lds, g, S, E);
#endif
        }
        GSYNC();
        {
            const Params p = load_params(); const int G = gridDim.x, c = obid();
            pg8::Gemm g{(const bf16*)(p.ws + WS_HB), (const bf16*)(p.ws + WS_W2) + (size_t)l * D * FF, M, D, FF}; pg8::StaticOrder S; S.init(M, D, G, c);
            EpiRes E{(const bf16*)(p.ws + WS_XN), (bf16*)(p.ws + WS_YB), p.b2 + l * D};
            pg8::gemm_phase<EpiRes, pg8::StaticOrder, true, true>(lds, g, S, E);
        }
        GSYNC();
        { const Params p = load_params(); ln_phase_b((const bf16*)(p.ws + WS_YB), (l == 0) ? nullptr : p.out, (l == 0) ? (bf16*)(p.ws + WS_XN) : nullptr, p.ln2_g + l * D, p.ln2_b + l * D); }
        if (l == 0) GSYNC();
    }
#if defined(MK_SANITIZE)
    GSYNC();
    { const Params p = load_params(); for (size_t i = (size_t)obid() * 512 + otid(); i < (size_t)M * D; i += (size_t)gridDim.x * 512) { float v = p.out[i]; if (!(fabsf(v) < 1e30f)) p.out[i] = 100.0f; } }
#endif
}

extern "C" void kernel_launch(void* const* d_in, const int* in_sizes, int n_in, void* d_out, int out_size, void* d_ws, size_t ws_size, hipStream_t stream) {
    static int grid = 0;
    if (grid == 0) {
        if (n_in != 19 || out_size != M * D || ws_size < WS_END) { fprintf(stderr, "kernel_launch: unexpected shapes (n_in %d out %d ws %zu)\n", n_in, out_size, ws_size); grid = -1; return; }
        int dev = 0, cus = 0, per_cu = 0;
        hipGetDevice(&dev);
        hipDeviceGetAttribute(&cus, hipDeviceAttributeMultiprocessorCount, dev);
        hipFuncSetAttribute((const void*)mega_fwd, hipFuncAttributeMaxDynamicSharedMemorySize, LDS_BYTES);
        hipOccupancyMaxActiveBlocksPerMultiprocessor(&per_cu, (const void*)mega_fwd, 512, LDS_BYTES);
        if (per_cu < 1) { fprintf(stderr, "kernel_launch: occupancy query says %d blocks per CU\n", per_cu); per_cu = 1; }
        grid = cus;
        (void)hipGetLastError();
    }
    if (grid < 0) return;
    Params p{};
    const float** pf = (const float**)&p;
    for (int i = 0; i < 19; ++i) pf[i] = (const float*)d_in[i];
    p.out = (float*)d_out; p.ws = (unsigned char*)d_ws;
    hipMemsetAsync(d_ws, 0, 16384, stream);
    void* args[] = {&p};
    hipError_t e = hipLaunchCooperativeKernel((const void*)mega_fwd, dim3(grid), dim3(512), args, LDS_BYTES, stream);
    if (e != hipSuccess) fprintf(stderr, "cooperative launch failed: %s (grid %d)\n", hipGetErrorString(e), grid);
}
```

```cpp
#include <hip/hip_runtime.h>
#include <hip/hip_cooperative_groups.h>
#include <cstdio>
#include <cstdint>
#include <cmath>
namespace pg8 {
#define PG8_LAS __attribute__((address_space(3)))
typedef unsigned short bf16_t;
typedef short bf16x8 __attribute__((ext_vector_type(8)));
typedef float f32x4 __attribute__((ext_vector_type(4)));
typedef unsigned u32x4 __attribute__((ext_vector_type(4)));
constexpr int BM = 256, BK = 64, HALF = 128, HTB = HALF * BK * 2  , STAGE_BYTES = 8 * HTB, NXCD = 8, WGM = 4;

__host__ __device__ __forceinline__ int lds_byte(int r, int c) { const int st = (r >> 4) * 2 + (c >> 5), rr = r & 15, cc = c & 31, ob = rr * 64 + cc * 2; return st * 1024 + (ob ^ (((ob >> 9) & 1) << 5)); }
__host__ __device__ __forceinline__ void stage_rc(int b, int& R, int& C) { const int st = b / 1024, sb = b % 1024, swz = sb ^ (((sb >> 9) & 1) << 5); R = (st >> 1) * 16 + swz / 64; C = (st & 1) * 32 + (swz % 64) / 2; }
__host__ __device__ __forceinline__ int perm32(int rho) { const int n = rho >> 4, i = rho & 15; return 8 * (i >> 2) + 4 * n + (i & 3); }

struct Unit { int pm, pn; };
struct Gemm { const bf16_t* A; const bf16_t* Bt; int M, N, K; };

struct StaticOrder {
    int nM, nN, nwg, G, c;
    __host__ __device__ void init(int M, int N, int G_, int c_) { nM = M / BM; nN = N / BM; nwg = nM * nN; G = G_; c = c_; }
    __host__ __device__ bool next(int i, Unit& u) const {
        const long L = (long)i * G + c; if (L >= nwg) return false;
        int wgid = (int)L; { const int q = nwg / NXCD, r = nwg % NXCD, xcd = wgid % NXCD, off = wgid / NXCD; wgid = (xcd < r ? xcd * (q + 1) : r * (q + 1) + (xcd - r) * q) + off; }
        const int nig = WGM * nN, gid = wgid / nig, fm = gid * WGM, gsz = (nM - fm) < WGM ? (nM - fm) : WGM;
        u.pm = fm + ((wgid % nig) % gsz); u.pn = (wgid % nig) / gsz; return true;
    }
    __device__ __forceinline__ void a_ready(const Unit&) const {}
    __device__ __forceinline__ void done(const Unit&) const {}
};

__device__ __forceinline__ unsigned cvt_pk_bf16(float lo, float hi) { unsigned r; asm volatile("v_cvt_pk_bf16_f32 %0, %1, %2" : "=v"(r) : "v"(lo), "v"(hi)); return r; }
typedef float f32x2 __attribute__((ext_vector_type(2)));
template <class Epi, class Sched, bool ALIGN_EPI = false, bool SP2 = false>
__device__ __forceinline__ void gemm_phase(PG8_LAS unsigned char* lds, const Gemm g, const Sched& S, const Epi& E) {
    int tid_ = threadIdx.x; asm volatile("" : "+v"(tid_)); const int tid = tid_, wid = __builtin_amdgcn_readfirstlane(tid >> 6), lane = tid & 63, wr = wid >> 2, wc = wid & 3, fr = lane & 15, fq = lane >> 4;
    const int K = g.K, nt = K / BK;
    unsigned voffA[2], voffB[2];
#pragma unroll
    for (int i = 0; i < 2; ++i) { int R, C; stage_rc(tid * 16 + i * 8192, R, C); const int Rb = Epi::PERM ? ((R & ~31) + perm32(R & 31)) : R;
        voffA[i] = (unsigned)(R * K + C) * 2u; voffB[i] = (unsigned)(Rb * K + C) * 2u; }
    const size_t kstep = (size_t)(BK * 2);
    const size_t hstep = (size_t)HALF * K * 2;
    const size_t tstep = 2 * hstep;
    const unsigned ldsw = (unsigned)wid * 1024u;
    const int aoff = lds_byte(wr * 64 + fr, fq * 8), boff = lds_byte(wc * 32 + fr, fq * 8);
#define PG8_SA(b, h) (((b) * 2 + (h)) * HTB)
#define PG8_SB(b, h) ((4 + (b) * 2 + (h)) * HTB)
#define PG8_STAGE(bufoff, gbase, voff) do { _Pragma("unroll") for (int _i = 0; _i < 2; ++_i) \
        __builtin_amdgcn_global_load_lds((const unsigned*)((const char*)(gbase) + (voff)[_i]), (PG8_LAS unsigned*)(lds + (bufoff) + ldsw + _i * 8192), 16, 0, 0); } while (0)
#define PG8_LDA(dst, b, h) do { _Pragma("unroll") for (int m = 0; m < 4; ++m) _Pragma("unroll") for (int k = 0; k < 2; ++k) dst[m][k] = *(const PG8_LAS bf16x8*)(lds + PG8_SA(b, h) + aoff + m * 2048 + k * 1024); } while (0)
#define PG8_LDB(dst, b, h) do { _Pragma("unroll") for (int n = 0; n < 2; ++n) _Pragma("unroll") for (int k = 0; k < 2; ++k) dst[n][k] = *(const PG8_LAS bf16x8*)(lds + PG8_SB(b, h) + boff + n * 2048 + k * 1024); } while (0)
#define PG8_MMA(ai, bj, At, Bt) do { __builtin_amdgcn_s_setprio(1); _Pragma("unroll") for (int m = 0; m < 4; ++m) _Pragma("unroll") for (int n = 0; n < 2; ++n) _Pragma("unroll") for (int k = 0; k < 2; ++k) \
        acc[ai][bj][m][n] = __builtin_amdgcn_mfma_f32_16x16x32_bf16(Bt[n][k], At[m][k], acc[ai][bj][m][n], 0, 0, 0); __builtin_amdgcn_s_setprio(0); } while (0)
#define PG8_WAIT_V(n) asm volatile("s_waitcnt vmcnt(" #n ")" ::: "memory")
#define PG8_WAIT_L(n) asm volatile("s_waitcnt lgkmcnt(" #n ")" ::: "memory")
#define PG8_BAR __builtin_amdgcn_s_barrier()
#define PG8_SCHED __builtin_amdgcn_sched_barrier(0)
    Unit cur, nxt; int ui = 0;
    if (!S.next(0, cur)) return;
    f32x4 acc[2][2][4][2];
#pragma unroll
    for (int a = 0; a < 2; ++a)
#pragma unroll
        for (int b = 0; b < 2; ++b)
#pragma unroll
            for (int m = 0; m < 4; ++m)
#pragma unroll
                for (int n = 0; n < 2; ++n) acc[a][b][m][n] = (f32x4){0.f, 0.f, 0.f, 0.f};
    bf16x8 At[4][2], B0[2][2], B1[2][2];
    const char* cA = (const char*)g.A + (size_t)cur.pm * tstep; const char* cB = (const char*)g.Bt + (size_t)cur.pn * tstep;
    S.a_ready(cur);
    if constexpr (SP2) {
        PG8_STAGE(PG8_SB(0, 0), cB, voffB); PG8_STAGE(PG8_SB(0, 1), cB + hstep, voffB); PG8_STAGE(PG8_SA(0, 0), cA, voffA); PG8_STAGE(PG8_SA(0, 1), cA + hstep, voffA);
        if (wr == 1) PG8_BAR;
        PG8_WAIT_V(2); PG8_BAR;
        PG8_STAGE(PG8_SB(1, 0), cB + kstep, voffB); PG8_STAGE(PG8_SA(1, 0), cA + kstep, voffA); PG8_STAGE(PG8_SB(1, 1), cB + hstep + kstep, voffB);
        PG8_WAIT_V(6); PG8_BAR;
    } else {
        PG8_STAGE(PG8_SB(0, 0), cB, voffB); PG8_STAGE(PG8_SA(0, 0), cA, voffA); PG8_STAGE(PG8_SB(0, 1), cB + hstep, voffB); PG8_STAGE(PG8_SA(0, 1), cA + hstep, voffA);
        if (wr == 1) PG8_BAR;
        PG8_WAIT_V(4); PG8_BAR;
        PG8_STAGE(PG8_SB(1, 0), cB + kstep, voffB); PG8_STAGE(PG8_SA(1, 0), cA + kstep, voffA); PG8_STAGE(PG8_SB(1, 1), cB + hstep + kstep, voffB);
        PG8_WAIT_V(6); PG8_BAR;
    }
    for (;;) {
        const bool has_next = S.next(ui + 1, nxt);
        const char* nA = has_next ? (const char*)g.A + (size_t)nxt.pm * tstep : cA; const char* nB = has_next ? (const char*)g.Bt + (size_t)nxt.pn * tstep : cB;
        for (int t = 0; t < nt; t += 2) {
            const bool last = (t == nt - 2);
            const char* a1 = cA + (size_t)(t + 1) * kstep;
            const char* a2 = last ? nA : cA + (size_t)(t + 2) * kstep; const char* b2 = last ? nB : cB + (size_t)(t + 2) * kstep;
            const char* a3 = a2 + kstep; const char* b3 = b2 + kstep;
            if (last && has_next) S.a_ready(nxt);
            if constexpr (SP2) {
            PG8_LDB(B0, 0, 0); PG8_LDB(B1, 0, 1); PG8_SCHED; PG8_LDA(At, 0, 0); PG8_STAGE(PG8_SA(1, 1), a1 + hstep, voffA);
            PG8_WAIT_V(8); PG8_WAIT_L(0); PG8_BAR; PG8_MMA(0, 0, At, B0); PG8_MMA(0, 1, At, B1); PG8_BAR; PG8_SCHED;
            PG8_LDA(At, 0, 1); PG8_STAGE(PG8_SB(0, 0), b2, voffB); PG8_STAGE(PG8_SB(0, 1), b2 + hstep, voffB); PG8_STAGE(PG8_SA(0, 0), a2, voffA);
            PG8_WAIT_V(8); PG8_WAIT_L(0); PG8_BAR; PG8_MMA(1, 0, At, B0); PG8_MMA(1, 1, At, B1); PG8_BAR; PG8_SCHED;
            PG8_LDB(B0, 1, 0); PG8_LDB(B1, 1, 1); PG8_SCHED; PG8_LDA(At, 1, 0); PG8_STAGE(PG8_SA(0, 1), a2 + hstep, voffA);
            PG8_WAIT_V(8); PG8_WAIT_L(0); PG8_BAR; PG8_MMA(0, 0, At, B0); PG8_MMA(0, 1, At, B1); PG8_BAR; PG8_SCHED;
            PG8_LDA(At, 1, 1); PG8_STAGE(PG8_SB(1, 0), b3, voffB); PG8_STAGE(PG8_SB(1, 1), b3 + hstep, voffB); PG8_STAGE(PG8_SA(1, 0), a3, voffA);
            PG8_WAIT_V(8); PG8_WAIT_L(0); PG8_BAR; PG8_MMA(1, 0, At, B0); PG8_MMA(1, 1, At, B1); PG8_BAR; PG8_SCHED;
            } else {
            PG8_LDB(B0, 0, 0); PG8_SCHED; PG8_LDA(At, 0, 0); PG8_STAGE(PG8_SA(1, 1), a1 + hstep, voffA);
            PG8_WAIT_L(8); PG8_BAR; PG8_WAIT_L(0); PG8_MMA(0, 0, At, B0); PG8_BAR; PG8_SCHED;
            PG8_LDB(B1, 0, 1); PG8_STAGE(PG8_SB(0, 0), b2, voffB);
            PG8_BAR; PG8_WAIT_L(0); PG8_MMA(0, 1, At, B1); PG8_BAR;
            PG8_LDA(At, 0, 1); PG8_STAGE(PG8_SA(0, 0), a2, voffA);
            PG8_BAR; PG8_WAIT_L(0); PG8_MMA(1, 0, At, B0); PG8_BAR; PG8_SCHED;
            PG8_STAGE(PG8_SB(0, 1), b2 + hstep, voffB);
            PG8_WAIT_V(6); PG8_BAR; PG8_MMA(1, 1, At, B1); PG8_BAR;
            PG8_LDB(B0, 1, 0); PG8_SCHED; PG8_LDA(At, 1, 0); PG8_STAGE(PG8_SA(0, 1), a2 + hstep, voffA);
            PG8_WAIT_L(8); PG8_BAR; PG8_WAIT_L(0); PG8_MMA(0, 0, At, B0); PG8_BAR; PG8_SCHED;
            PG8_LDB(B1, 1, 1); PG8_STAGE(PG8_SB(1, 0), b3, voffB);
            PG8_BAR; PG8_WAIT_L(0); PG8_MMA(0, 1, At, B1); PG8_BAR;
            PG8_LDA(At, 1, 1); PG8_STAGE(PG8_SA(1, 0), a3, voffA);
            PG8_BAR; PG8_WAIT_L(0); PG8_MMA(1, 0, At, B0); PG8_BAR; PG8_SCHED;
            PG8_STAGE(PG8_SB(1, 1), b3 + hstep, voffB);
            PG8_WAIT_V(6); PG8_BAR; PG8_MMA(1, 1, At, B1); PG8_BAR;
            }
        }
        if constexpr (ALIGN_EPI) { if (wr == 0) PG8_BAR; }
        if constexpr (!Epi::AFTER_DRAIN) { E(acc, cur, wr, wc, fr, fq); S.done(cur); }
        if (!has_next) break;
#pragma unroll
        for (int a = 0; a < 2; ++a)
#pragma unroll
            for (int b = 0; b < 2; ++b)
#pragma unroll
                for (int m = 0; m < 4; ++m)
#pragma unroll
                    for (int n = 0; n < 2; ++n) acc[a][b][m][n] = (f32x4){0.f, 0.f, 0.f, 0.f};
        cur = nxt; cA = nA; cB = nB; ++ui;
        if constexpr (ALIGN_EPI) { if (wr == 1) PG8_BAR; }
    }
    PG8_WAIT_V(0);
    if constexpr (!ALIGN_EPI) { if (wr == 0) PG8_BAR; }
    PG8_BAR;
    if constexpr (Epi::AFTER_DRAIN) { E.fused(acc, cur, wr, wc, fr, fq, lds, wid, lane); S.done(cur); }
#undef PG8_SA
#undef PG8_SB
#undef PG8_STAGE
#undef PG8_LDA
#undef PG8_LDB
#undef PG8_MMA
#undef PG8_WAIT_V
#undef PG8_WAIT_L
#undef PG8_BAR
#undef PG8_SCHED
}
}

namespace cg = cooperative_groups;
typedef unsigned short bf16;
typedef short bf16x8 __attribute__((ext_vector_type(8)));
typedef short s16x4 __attribute__((ext_vector_type(4)));
typedef float f32x4 __attribute__((ext_vector_type(4)));
typedef float f32x16 __attribute__((ext_vector_type(16)));
typedef unsigned u32x4 __attribute__((ext_vector_type(4)));
typedef unsigned u32x2 __attribute__((ext_vector_type(2)));
#define LAS __attribute__((address_space(3)))

constexpr int NB = 4, T = 8192, M = NB * T, D = 1024, FF = 4096;
constexpr int NIN = 3840;
constexpr float ALPHA = 1.41421356237309515f;
constexpr int LDS_BYTES = 147456;
constexpr int NSCAN = 64;

constexpr size_t MiB = 1u << 20;
constexpr size_t WS_WIN = 1 * MiB, WS_WOUT = 16 * MiB, WS_W1 = 20 * MiB, WS_W2 = 36 * MiB;
constexpr size_t WS_AB = 52 * MiB, WS_XN = 54 * MiB, WS_HZ = 118 * MiB, WS_HN = 150 * MiB, WS_HG = 246 * MiB;
constexpr size_t WS_RQ = 342 * MiB, WS_RK = 374 * MiB, WS_RV = 406 * MiB;
constexpr size_t WS_RTI = 438 * MiB, WS_RQK = 470 * MiB, WS_VEC = 502 * MiB;
constexpr size_t WS_HB = 150 * MiB;
constexpr size_t WS_YB = 406 * MiB;
constexpr size_t OUT_MIX = 64 * MiB;
constexpr size_t WS_END = 506 * MiB;

struct Params {
    const float *x, *ln_in_g, *ln_in_b, *w_in, *conv_w, *a_log, *dt_bias, *gdn_norm_g, *rpb, *na_norm_g, *w_out, *ln1_g, *ln1_b, *w1, *b1, *w2, *b2, *ln2_g, *ln2_b;
    float* out; unsigned char* ws;
};

typedef __bf16 bf16v2_t __attribute__((ext_vector_type(2)));
typedef float f32v2_t __attribute__((ext_vector_type(2)));
__device__ __forceinline__ unsigned pk2(float lo, float hi) { f32v2_t f = {lo, hi}; bf16v2_t b = __builtin_convertvector(f, bf16v2_t); return __builtin_bit_cast(unsigned, b); }
__device__ __forceinline__ unsigned short f2bf(float f) { return (unsigned short)(pk2(f, 0.f) & 0xffffu); }
__device__ __forceinline__ float bflo(unsigned u) { return __uint_as_float(u << 16); }
__device__ __forceinline__ float bfhi(unsigned u) { return __uint_as_float(u & 0xffff0000u); }
__device__ __forceinline__ int ppos(int o) { return (o & ~12) | ((o & 4) << 1) | ((o & 8) >> 1); }
__device__ __forceinline__ float wave_sum(float v) {
#pragma unroll
    for (int o = 1; o < 64; o <<= 1) v += __shfl_xor(v, o);
    return v;
}
__device__ __forceinline__ bf16x8 pack8(float a0, float a1, float a2, float a3, float a4, float a5, float a6, float a7) {
    u32x4 u; u.x = pk2(a0, a1); u.y = pk2(a2, a3); u.z = pk2(a4, a5); u.w = pk2(a6, a7);
    return __builtin_bit_cast(bf16x8, u);
}
#define MFMA32(a, b, c) __builtin_amdgcn_mfma_f32_32x32x16_bf16((a), (b), (c), 0, 0, 0)
#define MFMA16(a, b, c) __builtin_amdgcn_mfma_f32_16x16x32_bf16((a), (b), (c), 0, 0, 0)
typedef short v4i16_t __attribute__((ext_vector_type(4)));
__device__ __forceinline__ s16x4 trread(const LAS bf16* p) { return __builtin_bit_cast(s16x4, __builtin_amdgcn_ds_read_tr16_b64_v4i16((LAS v4i16_t*)p)); }
__device__ __forceinline__ bf16x8 cat8(s16x4 lo, s16x4 hi) { bf16x8 r; r[0] = lo[0]; r[1] = lo[1]; r[2] = lo[2]; r[3] = lo[3]; r[4] = hi[0]; r[5] = hi[1]; r[6] = hi[2]; r[7] = hi[3]; return r; }
#define LDS_BARRIER() do { asm volatile("s_waitcnt lgkmcnt(0)" ::: "memory"); __builtin_amdgcn_s_barrier(); asm volatile("" ::: "memory"); } while (0)
#define SBAR __builtin_amdgcn_sched_barrier(0)
#define WAVE_SYNC() do { __builtin_amdgcn_fence(__ATOMIC_RELEASE, "wavefront"); __builtin_amdgcn_wave_barrier(); __builtin_amdgcn_fence(__ATOMIC_ACQUIRE, "wavefront"); } while (0)

__device__ __forceinline__ int otid() { int t = threadIdx.x; asm volatile("" : "+v"(t)); return t; }
__device__ __forceinline__ int obid() { int t = blockIdx.x; asm volatile("" : "+s"(t)); return t; }

struct EpiIn {
    static constexpr bool PERM = true, AFTER_DRAIN = false;
    bf16 *HG, *HZ, *HN; float* AB; int pn_off;
    __device__ __forceinline__ void operator()(const f32x4 (&acc)[2][2][4][2], const pg8::Unit& u, int wr, int wc, int fr, int fq) const {
        const int row0 = u.pm * 256 + wr * 64 + fr;
        const int pn = u.pn + pn_off;
        if (pn != 12) {
            bf16* base; int ldc, colt;
            if (pn < 6) { base = HG; ldc = 1536; colt = pn * 256; }
            else if (pn < 12) { base = HN; ldc = 1536; colt = (pn - 6) * 256; }
            else { base = HZ; ldc = 512; colt = (pn - 13) * 256; }
            const int col0 = colt + wc * 32 + 8 * fq;
#pragma unroll
            for (int ai = 0; ai < 2; ++ai)
#pragma unroll
                for (int m = 0; m < 4; ++m) {
                    bf16* rowp = base + (size_t)(row0 + ai * 128 + m * 16) * ldc + col0;
#pragma unroll
                    for (int bj = 0; bj < 2; ++bj) {
                        const f32x4 v0 = acc[ai][bj][m][0], v1 = acc[ai][bj][m][1];
                        u32x4 w; w.x = pk2(v0[0], v0[1]); w.y = pk2(v0[2], v0[3]); w.z = pk2(v1[0], v1[1]); w.w = pk2(v1[2], v1[3]);
                        *(u32x4*)(rowp + bj * 128) = w;
                    }
                }
        } else {
            if (wc == 0 && fq < 2) {
#pragma unroll
                for (int ai = 0; ai < 2; ++ai)
#pragma unroll
                    for (int m = 0; m < 4; ++m) {
                        float* rp = AB + (size_t)(row0 + ai * 128 + m * 16) * 16 + 8 * fq;
                        *(f32x4*)(rp) = acc[ai][0][m][0];
                        *(f32x4*)(rp + 4) = acc[ai][0][m][1];
                    }
            }
        }
    }
};
struct EpiUp {
    static constexpr bool PERM = true, AFTER_DRAIN = false;
    bf16* O; const float* bias;
    __device__ __forceinline__ void operator()(const f32x4 (&acc)[2][2][4][2], const pg8::Unit& u, int wr, int wc, int fr, int fq) const {
        const int row0 = u.pm * 256 + wr * 64 + fr;
        const int col0 = u.pn * 256 + wc * 32 + 8 * fq;
        f32x4 bv[2][2];
#pragma unroll
        for (int bj = 0; bj < 2; ++bj)
#pragma unroll
            for (int n = 0; n < 2; ++n) bv[bj][n] = *(const f32x4*)(bias + col0 + bj * 128 + 4 * n);
#pragma unroll
        for (int ai = 0; ai < 2; ++ai)
#pragma unroll
            for (int m = 0; m < 4; ++m) {
                bf16* rowp = O + (size_t)(row0 + ai * 128 + m * 16) * FF + col0;
#pragma unroll
                for (int bj = 0; bj < 2; ++bj) {
                    f32x4 v0 = acc[ai][bj][m][0] + bv[bj][0], v1 = acc[ai][bj][m][1] + bv[bj][1];
#pragma unroll
                    for (int e = 0; e < 4; ++e) { const float a = fmaxf(v0[e], 0.f), b = fmaxf(v1[e], 0.f); v0[e] = a * a; v1[e] = b * b; }
                    u32x4 w; w.x = pk2(v0[0], v0[1]); w.y = pk2(v0[2], v0[3]); w.z = pk2(v1[0], v1[1]); w.w = pk2(v1[2], v1[3]);
                    *(u32x4*)(rowp + bj * 128) = w;
                }
            }
    }
};
struct EpiRes {
    static constexpr bool PERM = true, AFTER_DRAIN = false;
    const bf16* XR; bf16* Y; const float* bias;
    __device__ __forceinline__ void operator()(const f32x4 (&acc)[2][2][4][2], const pg8::Unit& u, int wr, int wc, int fr, int fq) const {
        const int row0 = u.pm * 256 + wr * 64 + fr;
        const int col0 = u.pn * 256 + wc * 32 + 8 * fq;
#pragma unroll
        for (int ai = 0; ai < 2; ++ai)
#pragma unroll
            for (int m = 0; m < 4; ++m) {
                const size_t off = (size_t)(row0 + ai * 128 + m * 16) * D + col0;
#pragma unroll
                for (int bj = 0; bj < 2; ++bj) {
                    const u32x4 xr = *(const u32x4*)(XR + off + bj * 128);
                    f32x4 b0 = {0.f, 0.f, 0.f, 0.f}, b1 = {0.f, 0.f, 0.f, 0.f};
                    if (bias) { b0 = *(const f32x4*)(bias + col0 + bj * 128); b1 = *(const f32x4*)(bias + col0 + bj * 128 + 4); }
                    const f32x4 v0 = acc[ai][bj][m][0] + b0, v1 = acc[ai][bj][m][1] + b1;
                    u32x4 w;
                    w.x = pk2(ALPHA * bflo(xr.x) + v0[0], ALPHA * bfhi(xr.x) + v0[1]); w.y = pk2(ALPHA * bflo(xr.y) + v0[2], ALPHA * bfhi(xr.y) + v0[3]);
                    w.z = pk2(ALPHA * bflo(xr.z) + v1[0], ALPHA * bfhi(xr.z) + v1[1]); w.w = pk2(ALPHA * bflo(xr.w) + v1[2], ALPHA * bfhi(xr.w) + v1[3]);
                    *(u32x4*)(Y + off + bj * 128) = w;
                }
            }
    }
};

__device__ __forceinline__ void tr_item(const float* W, int ld, int K, int src_col0, int nvalid, bf16* WT, int dst_row0, LAS float* scr, int kb, int nb, int lane) {
    const int k0 = 64 * kb, n0 = 32 * nb;
    const int nq = (lane & 7) * 4, n = n0 + nq;
#pragma unroll
    for (int i = 0; i < 8; ++i) {
        const int kk = 8 * i + (lane >> 3);
        f32x4 v = {0.f, 0.f, 0.f, 0.f};
        if (n < nvalid) v = *(const f32x4*)(W + (size_t)(k0 + kk) * ld + src_col0 + n);
        scr[kk * 33 + nq + 0] = v[0]; scr[kk * 33 + nq + 1] = v[1]; scr[kk * 33 + nq + 2] = v[2]; scr[kk * 33 + nq + 3] = v[3];
    }
    WAVE_SYNC();
    const int c = lane & 7;
#pragma unroll
    for (int j = 0; j < 4; ++j) {
        const int nn = (lane >> 3) + 8 * j; const LAS float* s = scr + (8 * c) * 33 + nn;
        u32x4 o; o.x = pk2(s[0 * 33], s[1 * 33]); o.y = pk2(s[2 * 33], s[3 * 33]); o.z = pk2(s[4 * 33], s[5 * 33]); o.w = pk2(s[6 * 33], s[7 * 33]);
        *(u32x4*)(WT + (size_t)(dst_row0 + n0 + nn) * K + k0 + 8 * c) = o;
    }
    WAVE_SYNC();
}
__device__ __forceinline__ void ln_row(const float* src, float* dstf, bf16* dstb, const float* g, const float* b, int lane) {
    f32x4 v[4]; float s = 0.f;
#pragma unroll
    for (int j = 0; j < 4; ++j) { v[j] = *(const f32x4*)(src + 4 * lane + 256 * j); s += (v[j][0] + v[j][1]) + (v[j][2] + v[j][3]); }
    const float mean = wave_sum(s) * (1.f / D); float s2 = 0.f;
#pragma unroll
    for (int j = 0; j < 4; ++j) { v[j] = v[j] - mean; s2 += (v[j][0] * v[j][0] + v[j][1] * v[j][1]) + (v[j][2] * v[j][2] + v[j][3] * v[j][3]); }
    const float rstd = 1.0f / sqrtf(wave_sum(s2) * (1.f / D) + 1e-5f);
#pragma unroll
    for (int j = 0; j < 4; ++j) {
        const f32x4 gv = *(const f32x4*)(g + 4 * lane + 256 * j), bv = *(const f32x4*)(b + 4 * lane + 256 * j);
        const f32x4 y = v[j] * rstd * gv + bv;
        if (dstf) *(f32x4*)(dstf + 4 * lane + 256 * j) = y;
        if (dstb) { u32x2 w; w.x = pk2(y[0], y[1]); w.y = pk2(y[2], y[3]); *(u32x2*)(dstb + 4 * lane + 256 * j) = w; }
    }
}
__device__ __forceinline__ void ln_row_b(const bf16* src, float* dstf, bf16* dstb, const float* g, const float* b, int lane) {
    float v[16]; float s = 0.f;
#pragma unroll
    for (int j = 0; j < 2; ++j) {
        const u32x4 u = *(const u32x4*)(src + 8 * lane + 512 * j);
#pragma unroll
        for (int k = 0; k < 4; ++k) { v[8 * j + 2 * k] = bflo(u[k]); v[8 * j + 2 * k + 1] = bfhi(u[k]); }
    }
#pragma unroll
    for (int k = 0; k < 16; ++k) s += v[k];
    const float mean = wave_sum(s) * (1.f / D); float s2 = 0.f;
#pragma unroll
    for (int k = 0; k < 16; ++k) { v[k] -= mean; s2 += v[k] * v[k]; }
    const float rstd = 1.0f / sqrtf(wave_sum(s2) * (1.f / D) + 1e-5f);
#pragma unroll
    for (int j = 0; j < 2; ++j) {
        const f32x4 g0 = *(const f32x4*)(g + 8 * lane + 512 * j), g1 = *(const f32x4*)(g + 8 * lane + 512 * j + 4);
        const f32x4 b0 = *(const f32x4*)(b + 8 * lane + 512 * j), b1 = *(const f32x4*)(b + 8 * lane + 512 * j + 4);
        f32x4 y0, y1;
#pragma unroll
        for (int k = 0; k < 4; ++k) { y0[k] = v[8 * j + k] * rstd * g0[k] + b0[k]; y1[k] = v[8 * j + 4 + k] * rstd * g1[k] + b1[k]; }
        if (dstf) { *(f32x4*)(dstf + 8 * lane + 512 * j) = y0; *(f32x4*)(dstf + 8 * lane + 512 * j + 4) = y1; }
        if (dstb) { u32x4 w; w.x = pk2(y0[0], y0[1]); w.y = pk2(y0[2], y0[3]); w.z = pk2(y1[0], y1[1]); w.w = pk2(y1[2], y1[3]); *(u32x4*)(dstb + 8 * lane + 512 * j) = w; }
    }
}
__device__ __forceinline__ void ln_phase_b(const bf16* src, float* dstf, bf16* dstb, const float* g, const float* b) {
    const int lane = otid() & 63, gw = obid() * 8 + (otid() >> 6), ngw = gridDim.x * 8;
    for (int m = gw; m < M; m += ngw) ln_row_b(src + (size_t)m * D, dstf ? dstf + (size_t)m * D : nullptr, dstb ? dstb + (size_t)m * D : nullptr, g, b, lane);
}
__device__ __forceinline__ void ln_phase(const float* src, float* dstf, bf16* dstb, const float* g, const float* b) {
    const int lane = otid() & 63, gw = obid() * 8 + (otid() >> 6), ngw = gridDim.x * 8;
    for (int m = gw; m < M; m += ngw) ln_row(src + (size_t)m * D, dstf ? dstf + (size_t)m * D : nullptr, dstb ? dstb + (size_t)m * D : nullptr, g, b, lane);
}
__device__ __forceinline__ void convert_weights(const Params& p, int l, LAS float* scr, int gw, int ngw, int lane, int part) {
    constexpr int I_A = 48 * 16, I_B = 48 * 16, I_C = 8 * 16, I_Z = 16 * 16, I_O = 32 * 16, I_1 = 128 * 16, I_2 = 32 * 64;
    constexpr int PER_L = I_A + I_B + I_C + I_Z + I_O + I_1 + I_2;
    const float* win = p.w_in + (size_t)l * D * 3600;
    bf16* winT = (bf16*)(p.ws + WS_WIN) + (size_t)l * NIN * D;
    const int lo = (part & 1) ? 0 : (I_A + I_B + I_C + I_Z), hi = (part & 2) ? PER_L : (I_A + I_B + I_C + I_Z);
    for (int it = lo + gw; it < hi; it += ngw) {
        int r = it;
        if (r < I_A) { tr_item(win, 3600, D, 0, 1536, winT, 0, scr, r / 48, r % 48, lane); continue; } r -= I_A;
        if (r < I_B) { tr_item(win, 3600, D, 2064, 1536, winT, 1536, scr, r / 48, r % 48, lane); continue; } r -= I_B;
        if (r < I_C) { tr_item(win, 3600, D, 2048, 16, winT, 3072, scr, r / 8, r % 8, lane); continue; } r -= I_C;
        if (r < I_Z) { tr_item(win, 3600, D, 1536, 512, winT, 3328, scr, r / 16, r % 16, lane); continue; } r -= I_Z;
        if (r < I_O) { tr_item(p.w_out + (size_t)l * D * D, D, D, 0, D, (bf16*)(p.ws + WS_WOUT) + (size_t)l * D * D, 0, scr, r / 32, r % 32, lane); continue; } r -= I_O;
        if (r < I_1) { tr_item(p.w1 + (size_t)l * D * FF, FF, D, 0, FF, (bf16*)(p.ws + WS_W1) + (size_t)l * D * FF, 0, scr, r / 128, r % 128, lane); continue; } r -= I_1;
        tr_item(p.w2 + (size_t)l * D * FF, D, FF, 0, D, (bf16*)(p.ws + WS_W2) + (size_t)l * D * FF, 0, scr, r / 32, r % 32, lane);
    }
}
__device__ __forceinline__ void phase0(const Params& p, LAS unsigned char* lds) {
    const int lane = otid() & 63, w = otid() >> 6, gw = obid() * 8 + w, ngw = gridDim.x * 8;
    convert_weights(p, 0, (LAS float*)(lds + w * 16384), gw, ngw, lane, 1);
    ln_phase(p.x, nullptr, (bf16*)(p.ws + WS_XN), p.ln_in_g, p.ln_in_b);
}

__device__ __forceinline__ void prep_phase(const Params& p, int layer, LAS unsigned char* lds, int mode = 7) {
    const int tid = otid(), lane = tid & 63, w = tid >> 6;
    LAS bf16* Qs = (LAS bf16*)lds;
    LAS bf16* Ks = Qs + 64 * 136;
    LAS bf16* Vs = Ks + 64 * 136;
    LAS float* gcs = (LAS float*)(lds + 3 * 64 * 136 * 2);
    LAS float* bts = gcs + 128;
    const float* convw = p.conv_w + (size_t)layer * 5 * 1536;
    const bf16* HG = (const bf16*)(p.ws + WS_HG);
    const float* AB = (const float*)(p.ws + WS_AB);
    float* Amat = (float*)((unsigned char*)p.out + OUT_MIX);
    bf16* recq = (bf16*)(p.ws + WS_RQ); bf16* reck = (bf16*)(p.ws + WS_RK); bf16* recv = (bf16*)(p.ws + WS_RV);
    bf16* recti = (bf16*)(p.ws + WS_RTI); bf16* recqk = (bf16*)(p.ws + WS_RQK); float* recvec = (float*)(p.ws + WS_VEC);
    int nit = 0;
    for (int item = obid(); item < 2048; item += gridDim.x, ++nit) {
        if (!(mode & 5)) continue;
        const int b = item >> 9, h = (item >> 7) & 3, n = item & 127;
        const int m0 = b * T + 64 * n;
        if (mode & 1) {
        if (w < 2) {
            const int dir = w, r = lane, c = dir ? 63 - r : r, m = m0 + c;
            const float a = AB[(size_t)m * 16 + dir * 4 + h], bb = AB[(size_t)m * 16 + 8 + dir * 4 + h];
            const float Aa = expf(p.a_log[layer * 8 + dir * 4 + h]);
            const float xx = a + p.dt_bias[layer * 8 + dir * 4 + h];
            const float sp = xx > 20.f ? xx : log1pf(expf(xx));
            const float g = -Aa * sp, beta = 1.f / (1.f + expf(-bb));
            float gc = g;
#pragma unroll
            for (int o = 1; o < 64; o <<= 1) { const float t = __shfl_up(gc, o); if (lane >= o) gc += t; }
            const float gl = __shfl(gc, 63);
            gcs[dir * 64 + r] = gc; bts[dir * 64 + r] = beta;
            float* vec = recvec + (size_t)(item * 2 + dir) * 256;
            vec[r] = expf(gc); vec[64 + r] = beta; vec[128 + r] = expf(gl - gc); if (r == 0) vec[192] = expf(gl);
        }
#pragma unroll
        for (int s = 0; s < 3; ++s) {
            const int col = s * 512 + h * 128 + 2 * lane;
            float w0[5], w1[5];
#pragma unroll
            for (int i = 0; i < 5; ++i) { w0[i] = convw[i * 1536 + col]; w1[i] = convw[i * 1536 + col + 1]; }
            float x0[12], x1[12];
#pragma unroll
            for (int i = 0; i < 12; ++i) {
                const int tl = 64 * n + 8 * w - 2 + i;
                unsigned u = 0u;
                if (tl >= 0 && tl < T) u = *(const unsigned*)(HG + (size_t)(b * T + tl) * 1536 + col);
                x0[i] = bflo(u); x1[i] = bfhi(u);
            }
            LAS bf16* dst = (s == 0) ? Qs : (s == 1 ? Ks : Vs);
            const int pos = (s < 2) ? ppos(2 * lane) : 2 * lane;
#pragma unroll
            for (int c8 = 0; c8 < 8; ++c8) {
                float y0 = 0.f, y1 = 0.f;
#pragma unroll
                for (int i = 0; i < 5; ++i) { y0 += w0[i] * x0[c8 + i]; y1 += w1[i] * x1[c8 + i]; }
                y0 = y0 * __builtin_amdgcn_rcpf(1.f + __expf(-y0)); y1 = y1 * __builtin_amdgcn_rcpf(1.f + __expf(-y1));
                if (s < 2) {
                    const float ss = wave_sum(y0 * y0 + y1 * y1);
                    float inv = __builtin_amdgcn_rsqf(ss + 1e-6f);
                    if (s == 0) inv *= 0.08838834764831845f;
                    y0 *= inv; y1 *= inv;
                }
                *(LAS unsigned*)(dst + (8 * w + c8) * 136 + pos) = pk2(y0, y1);
            }
        }
        }
        LDS_BARRIER();
        if (mode & 4) {
        {
            bf16* qr = recq + (size_t)item * 8192; bf16* kr = reck + (size_t)item * 8192; bf16* vr = recv + (size_t)item * 8192;
            for (int ch = tid; ch < 1024; ch += 512) {
                const int r = ch >> 4, cc = ch & 15;
                *(u32x4*)(qr + r * 128 + cc * 8) = *(const LAS u32x4*)(Qs + r * 136 + cc * 8);
                *(u32x4*)(kr + r * 128 + cc * 8) = *(const LAS u32x4*)(Ks + r * 136 + cc * 8);
            }
            const int v = tid & 127;
            for (int cgp = tid >> 7; cgp < 8; cgp += 4) {
                const int c0 = 8 * cgp; unsigned short e[8];
#pragma unroll
                for (int k = 0; k < 8; ++k) e[k] = Vs[(c0 + k) * 136 + v];
                u32x4 o; o.x = e[0] | ((unsigned)e[1] << 16); o.y = e[2] | ((unsigned)e[3] << 16); o.z = e[4] | ((unsigned)e[5] << 16); o.w = e[6] | ((unsigned)e[7] << 16);
                *(u32x4*)(vr + v * 64 + c0) = o;
            }
        }
        {
            int lo_ = lane; asm volatile("" : "+v"(lo_));
            const int mat = w >> 2, ti = (w >> 1) & 1, tj = w & 1, l31 = lo_ & 31, h2 = lo_ >> 5;
            const LAS bf16* X = mat ? Qs : Ks;
            f32x16 acc;
#pragma unroll
            for (int r = 0; r < 16; ++r) acc[r] = 0.f;
#pragma unroll
            for (int s = 0; s < 8; ++s) {
                const bf16x8 a = *(const LAS bf16x8*)(Ks + (32 * tj + l31) * 136 + 16 * s + 8 * h2);
                const bf16x8 bb = *(const LAS bf16x8*)(X + (32 * ti + l31) * 136 + 16 * s + 8 * h2);
                acc = MFMA32(a, bb, acc);
            }
            const int i = 32 * ti + l31;
#pragma unroll
            for (int dir = 0; dir < 2; ++dir) {
                const int ri = dir ? 63 - i : i; const float gci = gcs[dir * 64 + ri], bti = bts[dir * 64 + ri];
                const size_t id = (size_t)(item * 2 + dir);
#pragma unroll
                for (int q = 0; q < 4; ++q) {
                    const int j0 = 32 * tj + 8 * q + 4 * h2;
                    const int rj0 = dir ? 60 - j0 : j0;
                    const f32x4 gq = *(const LAS f32x4*)(gcs + dir * 64 + rj0);
                    f32x4 val;
#pragma unroll
                    for (int e = 0; e < 4; ++e) {
                        const int rj = rj0 + e;
                        const float a = acc[4 * q + (dir ? 3 - e : e)];
                        const float ex = __expf(fminf(gci - gq[e], 0.f));
                        val[e] = (mat == 0) ? ((rj < ri) ? bti * a * ex : 0.f) : ((rj <= ri) ? a * ex : 0.f);
                    }
                    if (mat == 0) *(f32x4*)(Amat + id * 4096 + ri * 64 + rj0) = val;
                    else { u32x2 wv; wv.x = pk2(val[0], val[1]); wv.y = pk2(val[2], val[3]); *(u32x2*)(recqk + id * 4096 + ri * 64 + ppos(rj0)) = wv; }
                }
            }
        }
        }
        LDS_BARRIER();
    }
    __syncthreads();
    {

        for (int sidx = w; sidx < ((mode & 2) ? 2 * nit : 0); sidx += 8) {
            const int item = obid() + (sidx >> 1) * gridDim.x, dir = sidx & 1;
            const size_t id = (size_t)(item * 2 + dir);
            const float* Ag = Amat + id * 4096;
            float x[64];
            const float lanef = (float)lane;
            float rowv[8];
#pragma unroll
            for (int q = 0; q < 8; ++q) rowv[q] = Ag[q * 64 + lane];
#pragma unroll
            for (int i = 0; i < 64; ++i) {
                const float rv = rowv[i & 7];
                if (i + 8 < 64) rowv[i & 7] = Ag[(i + 8) * 64 + lane];
                float a0 = fmaxf(1.f - fabsf(lanef - (float)i), 0.f), a1 = 0.f, a2 = 0.f, a3 = 0.f;
#pragma unroll
                for (int j = 0; j < i; ++j) {
                    const float s = __builtin_bit_cast(float, __builtin_amdgcn_readlane(__builtin_bit_cast(int, rv), j));
                    if ((j & 3) == 0) a0 = fmaf(-s, x[j], a0); else if ((j & 3) == 1) a1 = fmaf(-s, x[j], a1); else if ((j & 3) == 2) a2 = fmaf(-s, x[j], a2); else a3 = fmaf(-s, x[j], a3);
                }
                x[i] = (a0 + a1) + (a2 + a3);
            }
            bf16* tr = recti + id * 4096; const int pos = ppos(lane);
#pragma unroll
            for (int i = 0; i < 64; ++i) tr[i * 64 + pos] = f2bf(x[i]);
        }
    }
}

constexpr int SC_BUF = 72704, SC_Q = 0, SC_K = 17408, SC_TI = 34816, SC_QK = 44032, SC_VEC = 53248, SC_V = 54272;
struct ScanRegs { u32x4 rq[4], rk[4], rt[2], rqk[2], rvv[4]; float rv; };
template <int dir> __device__ __forceinline__ void scan_fetch(const Params& p, int b, int h, int n, int lt, ScanRegs& R) {
    const int nt = dir ? 127 - n : n; const size_t item = (size_t)((b * 4 + h) * 128 + nt); const size_t id = item * 2 + dir;
    const bf16* qr = (const bf16*)(p.ws + WS_RQ) + item * 8192; const bf16* kr = (const bf16*)(p.ws + WS_RK) + item * 8192;
    const bf16* tr = (const bf16*)(p.ws + WS_RTI) + id * 4096; const bf16* qk = (const bf16*)(p.ws + WS_RQK) + id * 4096;
    const float* vec = (const float*)(p.ws + WS_VEC) + id * 256;
    const bf16* vt = (const bf16*)(p.ws + WS_RV) + item * 8192;
#pragma unroll
    for (int i = 0; i < 4; ++i) { const int ch = lt + 256 * i; R.rvv[i] = *(const u32x4*)(vt + ch * 8); }
#pragma unroll
    for (int i = 0; i < 4; ++i) { const int ch = lt + 256 * i, r = ch >> 4, cc = ch & 15, sr = dir ? 63 - r : r; R.rq[i] = *(const u32x4*)(qr + sr * 128 + cc * 8); R.rk[i] = *(const u32x4*)(kr + sr * 128 + cc * 8); }
#pragma unroll
    for (int i = 0; i < 2; ++i) { const int ch = lt + 256 * i, r = ch >> 3, cc = ch & 7; R.rt[i] = *(const u32x4*)(tr + r * 64 + cc * 8); R.rqk[i] = *(const u32x4*)(qk + r * 64 + cc * 8); }
    R.rv = (lt < 193) ? vec[lt] : 0.f;
}
__device__ __forceinline__ void scan_store(LAS unsigned char* buf, int lt, const ScanRegs& R) {
#pragma unroll
    for (int i = 0; i < 4; ++i) { const int ch = lt + 256 * i, r = ch >> 4, cc = ch & 15; *(LAS u32x4*)(buf + SC_Q + (r * 136 + cc * 8) * 2) = R.rq[i]; *(LAS u32x4*)(buf + SC_K + (r * 136 + cc * 8) * 2) = R.rk[i]; }
#pragma unroll
    for (int i = 0; i < 2; ++i) { const int ch = lt + 256 * i, r = ch >> 3, cc = ch & 7; *(LAS u32x4*)(buf + SC_TI + (r * 72 + cc * 8) * 2) = R.rt[i]; *(LAS u32x4*)(buf + SC_QK + (r * 72 + cc * 8) * 2) = R.rqk[i]; }
    *(LAS float*)(buf + SC_VEC + lt * 4) = R.rv;
#pragma unroll
    for (int i = 0; i < 4; ++i) { const int ch = lt + 256 * i, v = ch >> 3, cc = ch & 7; *(LAS u32x4*)(buf + SC_V + v * 144 + cc * 16) = R.rvv[i]; }
}
template <int dir, int smode = 7> __device__ __forceinline__ void scan_chain(const Params& p, int layer, LAS unsigned char* lds, int chain) {
    const int tid = otid(), lane = tid & 63, w = __builtin_amdgcn_readfirstlane(tid >> 6);
    const int half = chain & 1; chain >>= 1;
    const int b = chain >> 3, h = (chain >> 1) & 3;
    const int l31 = lane & 31, h2 = lane >> 5, vcol = 64 * half + 32 * (w & 1) + l31;
    bf16* og = (bf16*)(p.ws + WS_HG) + (size_t)dir * M * 512;
    if (w >= 4) {
        if (!(smode & 1)) { LDS_BARRIER(); for (int n = 0; n < 128; ++n) LDS_BARRIER(); return; }
        ScanRegs R0, R1;
        scan_fetch<dir>(p, b, h, 0, tid - 256, R0); scan_store(lds, tid - 256, R0); scan_fetch<dir>(p, b, h, 1, tid - 256, R0); scan_fetch<dir>(p, b, h, 2, tid - 256, R1);
        LDS_BARRIER();
#pragma unroll 1
        for (int n = 0; n < 128; n += 2) {
            scan_store(lds + SC_BUF, tid - 256, R0);
            if (n + 3 < 128) scan_fetch<dir>(p, b, h, n + 3, tid - 256, R0);
            LDS_BARRIER();
            if (n + 2 < 128) scan_store(lds, tid - 256, R1);
            if (n + 4 < 128) scan_fetch<dir>(p, b, h, n + 4, tid - 256, R1);
            LDS_BARRIER();
        }
    } else if (w >= 2) {
        LDS_BARRIER();
#pragma unroll 1
        for (int n = 0; n < 128; ++n) LDS_BARRIER();
    } else {
        if (!(smode & 2)) { LDS_BARRIER(); for (int n = 0; n < 128; ++n) LDS_BARRIER(); return; }
        f32x16 S[4];
#pragma unroll
        for (int k = 0; k < 4; ++k)
#pragma unroll
            for (int r = 0; r < 16; ++r) S[k][r] = 0.f;
        LDS_BARRIER();
#pragma unroll 1
        for (int n = 0; n < 128; ++n) {
            const LAS unsigned char* buf = lds + (n & 1) * SC_BUF;
            const LAS bf16* Qp = (const LAS bf16*)(buf + SC_Q); const LAS bf16* Kp = (const LAS bf16*)(buf + SC_K);
            const LAS bf16* Ti = (const LAS bf16*)(buf + SC_TI); const LAS bf16* QKm = (const LAS bf16*)(buf + SC_QK);
            const LAS float* vecl = (const LAS float*)(buf + SC_VEC);
            const float gl = vecl[192];
            bf16x8 Sb[8];
#pragma unroll
            for (int kt = 0; kt < 4; ++kt)
#pragma unroll
                for (int s = 0; s < 2; ++s) Sb[2 * kt + s] = pack8(S[kt][8 * s + 0], S[kt][8 * s + 1], S[kt][8 * s + 2], S[kt][8 * s + 3], S[kt][8 * s + 4], S[kt][8 * s + 5], S[kt][8 * s + 6], S[kt][8 * s + 7]);
            SBAR;
            f32x16 kA, kB;
#pragma unroll
            for (int r = 0; r < 16; ++r) { kA[r] = 0.f; kB[r] = 0.f; }
#pragma unroll
            for (int hf = 0; hf < 2; ++hf) {
                bf16x8 f0[4], f1[4];
#pragma unroll
                for (int k4 = 0; k4 < 4; ++k4) {
                    f0[k4] = *(const LAS bf16x8*)(Kp + (l31) * 136 + 16 * (4 * hf + k4) + 8 * h2);
                    f1[k4] = *(const LAS bf16x8*)(Kp + (32 + l31) * 136 + 16 * (4 * hf + k4) + 8 * h2);
                }
                SBAR;
#pragma unroll
                for (int k4 = 0; k4 < 4; ++k4) { kA = MFMA32(f0[k4], Sb[4 * hf + k4], kA); kB = MFMA32(f1[k4], Sb[4 * hf + k4], kB); }
                SBAR;
            }
            f32x16 qA, qB;
#pragma unroll
            for (int r = 0; r < 16; ++r) { qA[r] = 0.f; qB[r] = 0.f; }
            bf16x8 tb[4];
#pragma unroll
            for (int pt = 0; pt < 4; ++pt) {
                const int mt = pt >> 1, s = pt & 1;
                bf16x8 f0[2], f1[2];
#pragma unroll
                for (int k2 = 0; k2 < 2; ++k2) {
                    f0[k2] = *(const LAS bf16x8*)(Qp + (l31) * 136 + 16 * (2 * pt + k2) + 8 * h2);
                    f1[k2] = *(const LAS bf16x8*)(Qp + (32 + l31) * 136 + 16 * (2 * pt + k2) + 8 * h2);
                }
                f32x4 eg[2], bt[2]; u32x2 vq[2];
#pragma unroll
                for (int qq = 0; qq < 2; ++qq) {
                    const int q = 2 * s + qq;
                    eg[qq] = *(const LAS f32x4*)(vecl + 32 * mt + 8 * q + 4 * h2); bt[qq] = *(const LAS f32x4*)(vecl + 64 + 32 * mt + 8 * q + 4 * h2);
                    vq[qq] = *(const LAS u32x2*)(buf + SC_V + vcol * 144 + (dir ? 60 - (32 * mt + 8 * q + 4 * h2) : (32 * mt + 8 * q + 4 * h2)) * 2);
                }
                SBAR;
#pragma unroll
                for (int k2 = 0; k2 < 2; ++k2) { qA = MFMA32(f0[k2], Sb[2 * pt + k2], qA); qB = MFMA32(f1[k2], Sb[2 * pt + k2], qB); }
                float t8[8];
#pragma unroll
                for (int qq = 0; qq < 2; ++qq) {
                    const u32x2 u = vq[qq];
                    const float e0 = bflo(u.x), e1 = bfhi(u.x), e2 = bflo(u.y), e3 = bfhi(u.y);
                    f32x4 vv; vv[0] = dir ? e3 : e0; vv[1] = dir ? e2 : e1; vv[2] = dir ? e1 : e2; vv[3] = dir ? e0 : e3;
#pragma unroll
                    for (int e = 0; e < 4; ++e) { const float ksv = mt ? kB[8 * s + 4 * qq + e] : kA[8 * s + 4 * qq + e]; t8[4 * qq + e] = bt[qq][e] * (vv[e] - eg[qq][e] * ksv); }
                }
                tb[pt] = pack8(t8[0], t8[1], t8[2], t8[3], t8[4], t8[5], t8[6], t8[7]);
#pragma unroll
                for (int g = 0; g < 4; ++g) { __builtin_amdgcn_sched_group_barrier(0x8, 1, 0); __builtin_amdgcn_sched_group_barrier(0x2, 9, 0); }
                SBAR;
            }
            f32x16 vA, vB;
#pragma unroll
            for (int r = 0; r < 16; ++r) { vA[r] = 0.f; vB[r] = 0.f; }
            {
                bf16x8 f0[4], f1[4];
#pragma unroll
                for (int ks = 0; ks < 4; ++ks) {
                    f0[ks] = *(const LAS bf16x8*)(Ti + (l31) * 72 + 16 * ks + 8 * h2);
                    f1[ks] = *(const LAS bf16x8*)(Ti + (32 + l31) * 72 + 16 * ks + 8 * h2);
                }
                f32x4 egA[4], egB[4];
#pragma unroll
                for (int q = 0; q < 4; ++q) { egA[q] = *(const LAS f32x4*)(vecl + 8 * q + 4 * h2); egB[q] = *(const LAS f32x4*)(vecl + 32 + 8 * q + 4 * h2); }
                SBAR;
#pragma unroll
                for (int ks = 0; ks < 4; ++ks) { vA = MFMA32(f0[ks], tb[ks], vA); vB = MFMA32(f1[ks], tb[ks], vB); }
#pragma unroll
                for (int q = 0; q < 4; ++q)
#pragma unroll
                    for (int e = 0; e < 4; ++e) { qA[4 * q + e] *= egA[q][e]; qB[4 * q + e] *= egB[q][e]; }
#pragma unroll
                for (int kt = 0; kt < 4; ++kt)
#pragma unroll
                    for (int r = 0; r < 16; ++r) S[kt][r] *= gl;
#pragma unroll
                for (int g = 0; g < 8; ++g) { __builtin_amdgcn_sched_group_barrier(0x8, 1, 0); __builtin_amdgcn_sched_group_barrier(0x2, 6, 0); }
                SBAR;
            }
            bf16x8 vb[4], vsb[4];
            {
                f32x4 ekA[4], ekB[4];
#pragma unroll
                for (int q = 0; q < 4; ++q) { ekA[q] = *(const LAS f32x4*)(vecl + 128 + 8 * q + 4 * h2); ekB[q] = *(const LAS f32x4*)(vecl + 128 + 32 + 8 * q + 4 * h2); }
#pragma unroll
                for (int s = 0; s < 2; ++s) {
                    vb[s] = pack8(vA[8 * s + 0], vA[8 * s + 1], vA[8 * s + 2], vA[8 * s + 3], vA[8 * s + 4], vA[8 * s + 5], vA[8 * s + 6], vA[8 * s + 7]);
                    vb[2 + s] = pack8(vB[8 * s + 0], vB[8 * s + 1], vB[8 * s + 2], vB[8 * s + 3], vB[8 * s + 4], vB[8 * s + 5], vB[8 * s + 6], vB[8 * s + 7]);
                    vsb[s] = pack8(ekA[2 * s][0] * vA[8 * s + 0], ekA[2 * s][1] * vA[8 * s + 1], ekA[2 * s][2] * vA[8 * s + 2], ekA[2 * s][3] * vA[8 * s + 3], ekA[2 * s + 1][0] * vA[8 * s + 4], ekA[2 * s + 1][1] * vA[8 * s + 5], ekA[2 * s + 1][2] * vA[8 * s + 6], ekA[2 * s + 1][3] * vA[8 * s + 7]);
                    vsb[2 + s] = pack8(ekB[2 * s][0] * vB[8 * s + 0], ekB[2 * s][1] * vB[8 * s + 1], ekB[2 * s][2] * vB[8 * s + 2], ekB[2 * s][3] * vB[8 * s + 3], ekB[2 * s + 1][0] * vB[8 * s + 4], ekB[2 * s + 1][1] * vB[8 * s + 5], ekB[2 * s + 1][2] * vB[8 * s + 6], ekB[2 * s + 1][3] * vB[8 * s + 7]);
                }
            }
            SBAR;
            {
                const int g4 = lane >> 4, i16 = lane & 15, q4 = i16 >> 2, pp = i16 & 3, pq = ((pp & 1) << 1) | (pp >> 1);
                const LAS bf16* kb0 = Kp + (4 * h2 + q4) * 136 + 16 * (g4 & 1) + 4 * pq;
                const int nt = dir ? 127 - n : n;
                bf16* ob = og + (size_t)(b * T + 64 * nt) * 512 + h * 128 + vcol;
                s16x4 lo0[4], hi0[4], lo1[4], hi1[4];
#pragma unroll
                for (int ks = 0; ks < 4; ++ks) {
                    lo0[ks] = trread(kb0 + (16 * ks) * 136); hi0[ks] = trread(kb0 + (16 * ks + 8) * 136);
                    lo1[ks] = trread(kb0 + (16 * ks) * 136 + 32); hi1[ks] = trread(kb0 + (16 * ks + 8) * 136 + 32);
                }
                bf16x8 f0[4], f1[4];
#pragma unroll
                for (int ks = 0; ks < 4; ++ks) {
                    f0[ks] = *(const LAS bf16x8*)(QKm + (l31) * 72 + 16 * ks + 8 * h2);
                    f1[ks] = *(const LAS bf16x8*)(QKm + (32 + l31) * 72 + 16 * ks + 8 * h2);
                }
                SBAR;
#pragma unroll
                for (int ks = 0; ks < 4; ++ks) {
                    S[0] = MFMA32(cat8(lo0[ks], hi0[ks]), vsb[ks], S[0]);
                    S[1] = MFMA32(cat8(lo1[ks], hi1[ks]), vsb[ks], S[1]);
                }
#pragma unroll
                for (int ks = 0; ks < 4; ++ks) { qA = MFMA32(f0[ks], vb[ks], qA); qB = MFMA32(f1[ks], vb[ks], qB); }
                SBAR;
#pragma unroll
                for (int ks = 0; ks < 4; ++ks) {
                    lo0[ks] = trread(kb0 + (16 * ks) * 136 + 64); hi0[ks] = trread(kb0 + (16 * ks + 8) * 136 + 64);
                    lo1[ks] = trread(kb0 + (16 * ks) * 136 + 96); hi1[ks] = trread(kb0 + (16 * ks + 8) * 136 + 96);
                }
                SBAR;
#pragma unroll
                for (int ks = 0; ks < 4; ++ks) {
                    S[2] = MFMA32(cat8(lo0[ks], hi0[ks]), vsb[ks], S[2]);
                    S[3] = MFMA32(cat8(lo1[ks], hi1[ks]), vsb[ks], S[3]);
                }
                const int odd = lane & 1;
                bf16* obo = ob + (odd ? (dir ? -512 : 512) - 1 : 0);
#pragma unroll
                for (int mt = 0; mt < 2; ++mt)
#pragma unroll
                    for (int q = 0; q < 4; ++q)
#pragma unroll
                        for (int ep = 0; ep < 2; ++ep) {
                            const float x = mt ? qB[4 * q + 2 * ep] : qA[4 * q + 2 * ep], y = mt ? qB[4 * q + 2 * ep + 1] : qA[4 * q + 2 * ep + 1];
                            const float snd = odd ? x : y;
                            const float rcv = __builtin_bit_cast(float, __builtin_amdgcn_mov_dpp(__builtin_bit_cast(int, snd), 0xB1, 0xF, 0xF, true));
                            const unsigned pk = odd ? pk2(rcv, y) : pk2(x, rcv);
                            const int r = 32 * mt + 8 * q + 4 * h2 + 2 * ep; const int c = dir ? 63 - r : r;
                            if (smode & 4) *(unsigned*)(obo + (ptrdiff_t)c * 512) = pk;
                        }
                SBAR;
            }
            LDS_BARRIER();
        }
    }
}

__device__ __forceinline__ void na_items(const Params& p, int layer, LAS unsigned char* lds, int widx, int wstride) {
    const int lane = otid() & 63, w = otid() >> 6;
    const int fr = lane & 15, fq = lane >> 4;
    const LAS float* rp = (const LAS float*)lds;
    LAS bf16* Vst = (LAS bf16*)(lds + 16384 + w * 5120);
    const bf16* HN = (const bf16*)(p.ws + WS_HN);
    bf16* MIX = (bf16*)((unsigned char*)p.out + OUT_MIX);
    const float* ng = p.na_norm_g + layer * 64;
    for (int it = widx; it < 16384; it += wstride) {
        const int hh = it & 7, j = (it >> 3) & 3, r = (it >> 5) & 127, b = it >> 12;
        int r0 = r - 4; r0 = r0 < 0 ? 0 : (r0 > 120 ? 120 : r0);
        int ss = 16 * j - 8; ss = ss < 0 ? 0 : (ss > 32 ? 32 : ss);
        const int qc = 16 * j + fr;
        int wsn = qc - 8; wsn = wsn < 0 ? 0 : (wsn > 48 ? 48 : wsn);
        const size_t mq = (size_t)b * T + r * 64 + qc;
        bf16x8 Qf[2];
#pragma unroll
        for (int ks = 0; ks < 2; ++ks) Qf[ks] = *(const bf16x8*)(HN + mq * 1536 + hh * 64 + 32 * ks + 8 * fq);
        u32x4 vr[4][4];
#pragma unroll
        for (int i = 0; i < 4; ++i)
#pragma unroll
            for (int m4 = 0; m4 < 4; ++m4) {
                const int idx = lane + 64 * m4, key = idx >> 3, chn = idx & 7;
                const size_t mk = (size_t)b * T + (r0 + i) * 64 + ss + key;
                vr[i][m4] = *(const u32x4*)(HN + mk * 1536 + 1024 + hh * 64 + 8 * chn);
            }
        f32x4 sc[8][2];
#pragma unroll
        for (int i = 0; i < 8; ++i)
#pragma unroll
            for (int t = 0; t < 2; ++t) {
                const size_t mk = (size_t)b * T + (r0 + i) * 64 + ss + 16 * t + fr;
                const bf16x8 k0 = *(const bf16x8*)(HN + mk * 1536 + 512 + hh * 64 + 8 * fq);
                const bf16x8 k1 = *(const bf16x8*)(HN + mk * 1536 + 512 + hh * 64 + 32 + 8 * fq);
                f32x4 a = {0.f, 0.f, 0.f, 0.f};
                a = MFMA16(k0, Qf[0], a); a = MFMA16(k1, Qf[1], a);
                sc[i][t] = a;
            }
        float mx = -INFINITY;
#pragma unroll
        for (int i = 0; i < 8; ++i) {
            const int dr = r0 + i - r + 7;
            const LAS float* rb = rp + (hh * 15 + dr) * 31;
#pragma unroll
            for (int t = 0; t < 2; ++t)
#pragma unroll
                for (int e = 0; e < 4; ++e) {
                    const int kc = ss + 16 * t + 4 * fq + e;
                    int rel = kc - qc + 15; rel = rel < 0 ? 0 : (rel > 30 ? 30 : rel);
                    const bool valid = (kc >= wsn) && (kc < wsn + 16);
                    const float s = valid ? (sc[i][t][e] * 0.125f + rb[rel]) : -INFINITY;
                    sc[i][t][e] = s; mx = fmaxf(mx, s);
                }
        }
        mx = fmaxf(mx, __shfl_xor(mx, 16)); mx = fmaxf(mx, __shfl_xor(mx, 32));
        float sum = 0.f;
#pragma unroll
        for (int i = 0; i < 8; ++i)
#pragma unroll
            for (int t = 0; t < 2; ++t)
#pragma unroll
                for (int e = 0; e < 4; ++e) { const float pe = __expf(sc[i][t][e] - mx); sc[i][t][e] = pe; sum += pe; }
        sum += __shfl_xor(sum, 16); sum += __shfl_xor(sum, 32);
        f32x4 O[4];
#pragma unroll
        for (int dt = 0; dt < 4; ++dt) O[dt] = (f32x4){0.f, 0.f, 0.f, 0.f};
#pragma unroll
        for (int i = 0; i < 8; ++i) {
            WAVE_SYNC();
#pragma unroll
            for (int m4 = 0; m4 < 4; ++m4) { const int idx = lane + 64 * m4, key = idx >> 3, chn = idx & 7; *(LAS u32x4*)(Vst + key * 80 + chn * 8) = vr[i & 3][m4]; }
            if (i + 4 < 8) {
#pragma unroll
                for (int m4 = 0; m4 < 4; ++m4) {
                    const int idx = lane + 64 * m4, key = idx >> 3, chn = idx & 7;
                    const size_t mk = (size_t)b * T + (r0 + i + 4) * 64 + ss + key;
                    vr[i & 3][m4] = *(const u32x4*)(HN + mk * 1536 + 1024 + hh * 64 + 8 * chn);
                }
            }
            WAVE_SYNC();
            const f32x4 p0 = sc[i][0], p1 = sc[i][1];
            const bf16x8 Pf = pack8(p0[0], p0[1], p0[2], p0[3], p1[0], p1[1], p1[2], p1[3]);
            const int q4 = fr >> 2, pp = fr & 3;
#pragma unroll
            for (int dt = 0; dt < 4; ++dt) {
                const s16x4 lo = trread(Vst + (4 * fq + q4) * 80 + 16 * dt + 4 * pp);
                const s16x4 hi = trread(Vst + (16 + 4 * fq + q4) * 80 + 16 * dt + 4 * pp);
                O[dt] = MFMA16(Pf, cat8(lo, hi), O[dt]);
            }
        }
#pragma unroll
        for (int e = 0; e < 4; ++e) {
            const float sm = __shfl(sum, 4 * fq + e);
            const float inv = 1.0f / sm;
            float o0 = O[0][e] * inv, o1 = O[1][e] * inv, o2 = O[2][e] * inv, o3 = O[3][e] * inv;
            float ssq = o0 * o0 + o1 * o1 + o2 * o2 + o3 * o3;
            ssq += __shfl_xor(ssq, 1); ssq += __shfl_xor(ssq, 2); ssq += __shfl_xor(ssq, 4); ssq += __shfl_xor(ssq, 8);
            const float rs = 1.0f / sqrtf(ssq * (1.f / 64.f) + 1e-6f);
            const size_t mo = (size_t)b * T + r * 64 + 16 * j + 4 * fq + e;
            bf16* dst = MIX + mo * 1024 + 512 + hh * 64 + fr;
            dst[0] = f2bf(o0 * rs * ng[fr]); dst[16] = f2bf(o1 * rs * ng[16 + fr]); dst[32] = f2bf(o2 * rs * ng[32 + fr]); dst[48] = f2bf(o3 * rs * ng[48 + fr]);
        }
    }
}
template <int smode = 7> __device__ __forceinline__ void scan_na_phase(const Params& p, int layer, LAS unsigned char* lds, int mode = 3) {
    if (obid() < NSCAN) {
#if !defined(MK_NO_SCAN)
        if (!(mode & 1)) {} else if (obid() & 2) scan_chain<1, smode>(p, layer, lds, obid()); else scan_chain<0, smode>(p, layer, lds, obid());
#endif
    }
    else {
        const float* rpb = p.rpb + (size_t)layer * 8 * 15 * 31;
        for (int i = otid(); i < 8 * 15 * 31; i += 512) ((LAS float*)lds)[i] = rpb[i];
        __syncthreads();
#if !defined(MK_NO_NA)
        if (mode & 2) na_items(p, layer, lds, (obid() - NSCAN) * 8 + (otid() >> 6), ((int)gridDim.x - NSCAN) * 8);
        if ((mode & 2) && layer == 0 && smode == 7) {
            LAS float* scr = (LAS float*)(lds + 65536 + (otid() >> 6) * 8704); const int gw = (obid() - NSCAN) * 8 + (otid() >> 6), ngw = ((int)gridDim.x - NSCAN) * 8;
            convert_weights(p, 0, scr, gw, ngw, otid() & 63, 2);
            convert_weights(p, 1, scr, gw, ngw, otid() & 63, 3);
        }
        if ((mode & 2) && smode == 7) {
            __syncthreads();
            pg8::Gemm gz{(const bf16*)(p.ws + WS_XN), (const bf16*)(p.ws + WS_WIN) + (size_t)layer * NIN * D + (size_t)3328 * D, M, 512, D};
            pg8::StaticOrder Sz; Sz.init(M, 512, (int)gridDim.x - NSCAN, obid() - NSCAN);
            EpiIn Ez{(bf16*)(p.ws + WS_HG), (bf16*)(p.ws + WS_HZ), (bf16*)(p.ws + WS_HN), (float*)(p.ws + WS_AB), 13};
            pg8::gemm_phase<EpiIn, pg8::StaticOrder, true, true>(lds, gz, Sz, Ez);
        }
#endif
    }
}

__device__ __forceinline__ void combine_phase(const Params& p, int layer) {
    const int lane = otid() & 63, gw = obid() * 8 + (otid() >> 6), ngw = gridDim.x * 8;
    const bf16* og = (const bf16*)(p.ws + WS_HG); const bf16* HZ = (const bf16*)(p.ws + WS_HZ); bf16* MIX = (bf16*)((unsigned char*)p.out + OUT_MIX);
    const float* g = p.gdn_norm_g + layer * 128;
    const int col = 8 * lane;
    float gv[8];
#pragma unroll
    for (int k = 0; k < 8; ++k) gv[k] = g[(col & 127) + k];
    for (int m = gw; m < M; m += ngw) {
        const u32x4 a = *(const u32x4*)(og + (size_t)m * 512 + col), bq = *(const u32x4*)(og + (size_t)M * 512 + (size_t)m * 512 + col), z = *(const u32x4*)(HZ + (size_t)m * 512 + col);
        float o[8], zz[8];
#pragma unroll
        for (int k = 0; k < 4; ++k) { o[2 * k] = bflo(a[k]) + bflo(bq[k]); o[2 * k + 1] = bfhi(a[k]) + bfhi(bq[k]); zz[2 * k] = bflo(z[k]); zz[2 * k + 1] = bfhi(z[k]); }
        float ssq = 0.f;
#pragma unroll
        for (int k = 0; k < 8; ++k) ssq += o[k] * o[k];
        ssq += __shfl_xor(ssq, 1); ssq += __shfl_xor(ssq, 2); ssq += __shfl_xor(ssq, 4); ssq += __shfl_xor(ssq, 8);
        const float rs = 1.0f / sqrtf(ssq * (1.f / 128.f) + 1e-6f);
        float y[8];
#pragma unroll
        for (int k = 0; k < 8; ++k) { const float sz = zz[k] * __builtin_amdgcn_rcpf(1.f + __expf(-zz[k])); y[k] = o[k] * rs * gv[k] * sz; }
        u32x4 wv; wv.x = pk2(y[0], y[1]); wv.y = pk2(y[2], y[3]); wv.z = pk2(y[4], y[5]); wv.w = pk2(y[6], y[7]);
        *(u32x4*)(MIX + (size_t)m * 1024 + col) = wv;
    }
}

#define XB_TMO      128
#define XB_XCNT(j)  (256  + 64 * (j))
#define XB_XSUB(j)  (1280 + 64 * (j))
#define XB_XGEN(j)  (2304 + 64 * (j))
#define XB_TOP      3328
#define XB_TOPGEN   3392
#define XCD_BAR_WORDS 3456
#define XB_SPIN_CAP (1u << 18)

__device__ __forceinline__ unsigned xb_ld(unsigned* p)              { return __hip_atomic_load(p, __ATOMIC_RELAXED, __HIP_MEMORY_SCOPE_AGENT); }
__device__ __forceinline__ unsigned xb_add(unsigned* p, unsigned v) { return __hip_atomic_fetch_add(p, v, __ATOMIC_RELAXED, __HIP_MEMORY_SCOPE_AGENT); }
__device__ __forceinline__ unsigned xb_xcc_id() { return (unsigned)__builtin_amdgcn_s_getreg((3 << 11) | 20) & 0xFu; }
#define XB_SPIN(cond, bar) do { unsigned _sp = 0; while (cond) { __builtin_amdgcn_s_sleep(1); \
    if ((++_sp & 255u) == 0u) { if (xb_ld(&(bar)[XB_TMO])) break; if (_sp > XB_SPIN_CAP) { atomicAdd(&(bar)[XB_TMO], 1u); break; } } } } while (0)

struct XcdBarrier {
    unsigned* bar; unsigned x;
    volatile LAS unsigned* st;
};

__device__ __forceinline__ XcdBarrier xcd_barrier_post(unsigned* bar, volatile LAS unsigned* st) {
    XcdBarrier b; b.bar = bar; b.x = xb_xcc_id(); b.st = st;
    if (threadIdx.x == 0) (void)xb_add(&bar[XB_XCNT(b.x)], 1u);
    return b;
}
__device__ __forceinline__ void xcd_barrier_complete(unsigned* bar, unsigned x, unsigned& nloc, unsigned& nx) {
    const unsigned G = gridDim.x * gridDim.y * gridDim.z;
    unsigned sum, cnt, mine, sp = 0u;
    for (;;) {
        sum = 0u; cnt = 0u; mine = 0u;
#pragma unroll
        for (unsigned j = 0; j < 16; ++j) { const unsigned c = xb_ld(&bar[XB_XCNT(j)]); sum += c; cnt += (c > 0u) ? 1u : 0u; mine = (j == x) ? c : mine; }
        if (sum == G) break;
        __builtin_amdgcn_s_sleep(1);
        if ((++sp & 255u) == 0u) { if (xb_ld(&bar[XB_TMO])) break; if (sp > XB_SPIN_CAP) { atomicAdd(&bar[XB_TMO], 1u); break; } }
    }
    nloc = mine > 0u ? mine : 1u; nx = cnt > 0u ? cnt : 1u;
}

__device__ __forceinline__ void xcd_barrier(const XcdBarrier& b) {
    asm volatile("s_waitcnt vmcnt(0)" ::: "memory");
    __syncthreads();
    if (threadIdx.x == 0) {
        unsigned* bar = b.bar;
        __builtin_amdgcn_s_waitcnt(0);
        unsigned nloc = b.st[0], nx = b.st[1];
        if (nloc == 0u) { xcd_barrier_complete(bar, b.x, nloc, nx); b.st[0] = nloc; b.st[1] = nx; }
        const unsigned old = xb_add(&bar[XB_XSUB(b.x)], 1u);
        const unsigned gen = old / nloc;
        if (old + 1u == (gen + 1u) * nloc) {
            __builtin_amdgcn_fence(__ATOMIC_RELEASE, "agent");
            asm volatile("s_waitcnt vmcnt(0)" ::: "memory");
            const unsigned og = xb_add(&bar[XB_TOP], 1u);
            const unsigned tg = og / nx;
            if (og + 1u == (tg + 1u) * nx) xb_add(&bar[XB_TOPGEN], 1u);
            else XB_SPIN(xb_ld(&bar[XB_TOPGEN]) == tg, bar);
            __builtin_amdgcn_fence(__ATOMIC_ACQUIRE, "agent");
            xb_add(&bar[XB_XGEN(b.x)], 1u);
            asm volatile("s_waitcnt vmcnt(0)" ::: "memory");
        } else {
            XB_SPIN(xb_ld(&bar[XB_XGEN(b.x)]) == gen, bar);
            __builtin_amdgcn_fence(__ATOMIC_ACQUIRE, "agent");
            asm volatile("s_waitcnt vmcnt(0)" ::: "memory");
        }
    }
    __syncthreads();
}

typedef const __attribute__((address_space(4))) Params* KParamsPtr;
__device__ __forceinline__ Params load_params() {
#if defined(__HIP_DEVICE_COMPILE__)
    KParamsPtr kp = (KParamsPtr)__builtin_amdgcn_kernarg_segment_ptr(); asm volatile("" : "+s"(kp)); return *kp;
#else
    return Params{};
#endif
}
#if defined(MK_CG_SYNC)
#define GSYNC() grid.sync()
#else
#define GSYNC() xcd_barrier(xbar)
#endif
__global__ void __launch_bounds__(512, 2) mega_fwd(Params p_unused) {
    extern __shared__ __attribute__((aligned(16))) unsigned char lds_raw[];
    cg::grid_group grid = cg::this_grid();
    LAS unsigned char* lds = (LAS unsigned char*)lds_raw;
    volatile LAS unsigned* bst = (volatile LAS unsigned*)(lds + LDS_BYTES - 16);
    if (threadIdx.x == 0) { bst[0] = 0u; bst[1] = 0u; }
    __syncthreads();
    XcdBarrier xbar;
    { const Params p = load_params(); xbar = xcd_barrier_post((unsigned*)p.ws, bst); }
#if defined(MK_DUP_P0)
    { const Params p = load_params(); phase0(p, lds); }
    GSYNC();
#endif
    { const Params p = load_params(); phase0(p, lds); }
    GSYNC();
#if defined(MK_EXTRA_SYNCS)
    for (int i = 0; i < MK_EXTRA_SYNCS; ++i) GSYNC();
#endif
#pragma unroll 1
    for (int l = 0; l < 2; ++l) {
        {
            const Params p = load_params(); const int G = gridDim.x, c = obid();
            pg8::Gemm g{(const bf16*)(p.ws + WS_XN), (const bf16*)(p.ws + WS_WIN) + (size_t)l * NIN * D, M, 3328, D}; pg8::StaticOrder S; S.init(M, 3328, G, c);
            EpiIn E{(bf16*)(p.ws + WS_HG), (bf16*)(p.ws + WS_HZ), (bf16*)(p.ws + WS_HN), (float*)(p.ws + WS_AB), 0};
            pg8::gemm_phase<EpiIn, pg8::StaticOrder, true, true>(lds, g, S, E);
#if defined(MK_DUP_GIN)
            GSYNC();
            pg8::gemm_phase<EpiIn, pg8::StaticOrder, true, true>(lds, g, S, E);
#endif
        }
        GSYNC();
#if !defined(MK_SKIP_MIXER)
#if defined(MK_DUP_PREP_PRE)
        { const Params p = load_params(); prep_phase(p, l, lds, MK_DUP_PREP_PRE); }
        GSYNC();
#endif
#if !defined(MK_SKIP_PREP)
        { const Params p = load_params(); prep_phase(p, l, lds); }
        GSYNC();
#endif
#if defined(MK_DUP_PREP)
        { const Params p = load_params(); prep_phase(p, l, lds, MK_DUP_PREP); }
        GSYNC();
#endif
#if !defined(MK_SKIP_SCAN)
        { const Params p = load_params(); scan_na_phase(p, l, lds); }
        if (l == 0) grid.sync(); else GSYNC();
#endif
#if defined(MK_DUP_SCAN)
        { const Params p = load_params(); scan_na_phase<MK_DUP_SCAN>(p, l, lds, 1); }
        GSYNC();
#endif
#if defined(MK_DUP_NA)
        { const Params p = load_params(); scan_na_phase(p, l, lds, 2); }
        GSYNC();
#endif
        { const Params p = load_params(); combine_phase(p, l); }
        GSYNC();
#endif
        {
            const Params p = load_params(); const int G = gridDim.x, c = obid();
            pg8::Gemm g{(const bf16*)((unsigned char*)p.out + OUT_MIX), (const bf16*)(p.ws + WS_WOUT) + (size_t)l * D * D, M, D, D}; pg8::StaticOrder S; S.init(M, D, G, c);
            EpiRes E{(const bf16*)(p.ws + WS_XN), (bf16*)(p.ws + WS_YB), nullptr};
            pg8::gemm_phase<EpiRes, pg8::StaticOrder, true, true>(lds, g, S, E);
        }
        GSYNC();
        { const Params p = load_params(); ln_phase_b((const bf16*)(p.ws + WS_YB), nullptr, (bf16*)(p.ws + WS_XN), p.ln1_g + l * D, p.ln1_b + l * D); }
        GSYNC();
        {
            const Params p = load_params(); const int G = gridDim.x, c = obid();
            pg8::Gemm g{(const bf16*)(p.ws + WS_XN), (const bf16*)(p.ws + WS_W1) + (size_t)l * D * FF, M, FF, D}; pg8::StaticOrder S; S.init(M, FF, G, c);
            EpiUp E{(bf16*)(p.ws + WS_HB), p.b1 + l * FF};
            pg8::gemm_phase<EpiUp, pg8::StaticOrder, true, true>(lds, g, S, E);
#if defined(MK_DUP_GUP)
            GSYNC();
            pg8::gemm_phase<EpiUp, pg8::StaticOrder, true, true>(lds, g, S, E);
#endif
        }
        GSYNC();
        {
            const Params p = load_params(); const int G = gridDim.x, c = obid();
            pg8::Gemm g{(const bf16*)(p.ws + WS_HB), (const bf16*)(p.ws + WS_W2) + (size_t)l * D * FF, M, D, FF}; pg8::StaticOrder S; S.init(M, D, G, c);
            EpiRes E{(const bf16*)(p.ws + WS_XN), (bf16*)(p.ws + WS_YB), p.b2 + l * D};
            pg8::gemm_phase<EpiRes, pg8::StaticOrder, true, true>(lds, g, S, E);
        }
        GSYNC();
        { const Params p = load_params(); ln_phase_b((const bf16*)(p.ws + WS_YB), (l == 0) ? nullptr : p.out, (l == 0) ? (bf16*)(p.ws + WS_XN) : nullptr, p.ln2_g + l * D, p.ln2_b + l * D); }
        if (l == 0) GSYNC();
    }
#if defined(MK_SANITIZE)
    GSYNC();
    { const Params p = load_params(); for (size_t i = (size_t)obid() * 512 + otid(); i < (size_t)M * D; i += (size_t)gridDim.x * 512) { float v = p.out[i]; if (!(fabsf(v) < 1e30f)) p.out[i] = 100.0f; } }
#endif
}

extern "C" void kernel_launch(void* const* d_in, const int* in_sizes, int n_in, void* d_out, int out_size, void* d_ws, size_t ws_size, hipStream_t stream) {
    static int grid = 0;
    if (grid == 0) {
        if (n_in != 19 || out_size != M * D || ws_size < WS_END) { fprintf(stderr, "kernel_launch: unexpected shapes (n_in %d out %d ws %zu)\n", n_in, out_size, ws_size); grid = -1; return; }
        int dev = 0, cus = 0, per_cu = 0;
        hipGetDevice(&dev);
        hipDeviceGetAttribute(&cus, hipDeviceAttributeMultiprocessorCount, dev);
        hipFuncSetAttribute((const void*)mega_fwd, hipFuncAttributeMaxDynamicSharedMemorySize, LDS_BYTES);
        hipOccupancyMaxActiveBlocksPerMultiprocessor(&per_cu, (const void*)mega_fwd, 512, LDS_BYTES);
        if (per_cu < 1) { fprintf(stderr, "kernel_launch: occupancy query says %d blocks per CU\n", per_cu); per_cu = 1; }
        grid = cus;
        (void)hipGetLastError();
    }
    if (grid < 0) return;
    Params p{};
    const float** pf = (const float**)&p;
    for (int i = 0; i < 19; ++i) pf[i] = (const float*)d_in[i];
    p.out = (float*)d_out; p.ws = (unsigned char*)d_ws;
    hipMemsetAsync(d_ws, 0, 16384, stream);
    void* args[] = {&p};
    hipError_t e = hipLaunchCooperativeKernel((const void*)mega_fwd, dim3(grid), dim3(512), args, LDS_BYTES, stream);
    if (e != hipSuccess) fprintf(stderr, "cooperative launch failed: %s (grid %d)\n", hipGetErrorString(e), grid);
}
```

```cpp
#include <hip/hip_runtime.h>
#include <hip/hip_cooperative_groups.h>
#include <cstdio>
#include <cstdint>
#include <cmath>
namespace pg8 {
#define PG8_LAS __attribute__((address_space(3)))
typedef unsigned short bf16_t;
typedef short bf16x8 __attribute__((ext_vector_type(8)));
typedef float f32x4 __attribute__((ext_vector_type(4)));
typedef unsigned u32x4 __attribute__((ext_vector_type(4)));
constexpr int BM = 256, BK = 64, HALF = 128, HTB = HALF * BK * 2  , STAGE_BYTES = 8 * HTB, NXCD = 8, WGM = 4;

__host__ __device__ __forceinline__ int lds_byte(int r, int c) { const int st = (r >> 4) * 2 + (c >> 5), rr = r & 15, cc = c & 31, ob = rr * 64 + cc * 2; return st * 1024 + (ob ^ (((ob >> 9) & 1) << 5)); }
__host__ __device__ __forceinline__ void stage_rc(int b, int& R, int& C) { const int st = b / 1024, sb = b % 1024, swz = sb ^ (((sb >> 9) & 1) << 5); R = (st >> 1) * 16 + swz / 64; C = (st & 1) * 32 + (swz % 64) / 2; }
__host__ __device__ __forceinline__ int perm32(int rho) { const int n = rho >> 4, i = rho & 15; return 8 * (i >> 2) + 4 * n + (i & 3); }

struct Unit { int pm, pn; };
struct Gemm { const bf16_t* A; const bf16_t* Bt; int M, N, K; };

struct StaticOrder {
    int nM, nN, nwg, G, c;
    __host__ __device__ void init(int M, int N, int G_, int c_) { nM = M / BM; nN = N / BM; nwg = nM * nN; G = G_; c = c_; }
    __host__ __device__ bool next(int i, Unit& u) const {
        const long L = (long)i * G + c; if (L >= nwg) return false;
        int wgid = (int)L; { const int q = nwg / NXCD, r = nwg % NXCD, xcd = wgid % NXCD, off = wgid / NXCD; wgid = (xcd < r ? xcd * (q + 1) : r * (q + 1) + (xcd - r) * q) + off; }
        const int nig = WGM * nN, gid = wgid / nig, fm = gid * WGM, gsz = (nM - fm) < WGM ? (nM - fm) : WGM;
        u.pm = fm + ((wgid % nig) % gsz); u.pn = (wgid % nig) / gsz; return true;
    }
    __device__ __forceinline__ void a_ready(const Unit&) const {}
    __device__ __forceinline__ void done(const Unit&) const {}
};

__device__ __forceinline__ unsigned cvt_pk_bf16(float lo, float hi) { unsigned r; asm volatile("v_cvt_pk_bf16_f32 %0, %1, %2" : "=v"(r) : "v"(lo), "v"(hi)); return r; }
typedef float f32x2 __attribute__((ext_vector_type(2)));
template <class Epi, class Sched, bool ALIGN_EPI = false, bool SP2 = false>
__device__ __forceinline__ void gemm_phase(PG8_LAS unsigned char* lds, const Gemm g, const Sched& S, const Epi& E) {
    int tid_ = threadIdx.x; asm volatile("" : "+v"(tid_)); const int tid = tid_, wid = __builtin_amdgcn_readfirstlane(tid >> 6), lane = tid & 63, wr = wid >> 2, wc = wid & 3, fr = lane & 15, fq = lane >> 4;
    const int K = g.K, nt = K / BK;
    unsigned voffA[2], voffB[2];
#pragma unroll
    for (int i = 0; i < 2; ++i) { int R, C; stage_rc(tid * 16 + i * 8192, R, C); const int Rb = Epi::PERM ? ((R & ~31) + perm32(R & 31)) : R;
        voffA[i] = (unsigned)(R * K + C) * 2u; voffB[i] = (unsigned)(Rb * K + C) * 2u; }
    const size_t kstep = (size_t)(BK * 2);
    const size_t hstep = (size_t)HALF * K * 2;
    const size_t tstep = 2 * hstep;
    const unsigned ldsw = (unsigned)wid * 1024u;
    const int aoff = lds_byte(wr * 64 + fr, fq * 8), boff = lds_byte(wc * 32 + fr, fq * 8);
#define PG8_SA(b, h) (((b) * 2 + (h)) * HTB)
#define PG8_SB(b, h) ((4 + (b) * 2 + (h)) * HTB)
#define PG8_STAGE(bufoff, gbase, voff) do { _Pragma("unroll") for (int _i = 0; _i < 2; ++_i) \
        __builtin_amdgcn_global_load_lds((const unsigned*)((const char*)(gbase) + (voff)[_i]), (PG8_LAS unsigned*)(lds + (bufoff) + ldsw + _i * 8192), 16, 0, 0); } while (0)
#define PG8_LDA(dst, b, h) do { _Pragma("unroll") for (int m = 0; m < 4; ++m) _Pragma("unroll") for (int k = 0; k < 2; ++k) dst[m][k] = *(const PG8_LAS bf16x8*)(lds + PG8_SA(b, h) + aoff + m * 2048 + k * 1024); } while (0)
#define PG8_LDB(dst, b, h) do { _Pragma("unroll") for (int n = 0; n < 2; ++n) _Pragma("unroll") for (int k = 0; k < 2; ++k) dst[n][k] = *(const PG8_LAS bf16x8*)(lds + PG8_SB(b, h) + boff + n * 2048 + k * 1024); } while (0)
#define PG8_MMA(ai, bj, At, Bt) do { __builtin_amdgcn_s_setprio(1); _Pragma("unroll") for (int m = 0; m < 4; ++m) _Pragma("unroll") for (int n = 0; n < 2; ++n) _Pragma("unroll") for (int k = 0; k < 2; ++k) \
        acc[ai][bj][m][n] = __builtin_amdgcn_mfma_f32_16x16x32_bf16(Bt[n][k], At[m][k], acc[ai][bj][m][n], 0, 0, 0); __builtin_amdgcn_s_setprio(0); } while (0)
#define PG8_WAIT_V(n) asm volatile("s_waitcnt vmcnt(" #n ")" ::: "memory")
#define PG8_WAIT_L(n) asm volatile("s_waitcnt lgkmcnt(" #n ")" ::: "memory")
#define PG8_BAR __builtin_amdgcn_s_barrier()
#define PG8_SCHED __builtin_amdgcn_sched_barrier(0)
    Unit cur, nxt; int ui = 0;
    if (!S.next(0, cur)) return;
    f32x4 acc[2][2][4][2];
#pragma unroll
    for (int a = 0; a < 2; ++a)
#pragma unroll
        for (int b = 0; b < 2; ++b)
#pragma unroll
            for (int m = 0; m < 4; ++m)
#pragma unroll
                for (int n = 0; n < 2; ++n) acc[a][b][m][n] = (f32x4){0.f, 0.f, 0.f, 0.f};
    bf16x8 At[4][2], B0[2][2], B1[2][2];
    const char* cA = (const char*)g.A + (size_t)cur.pm * tstep; const char* cB = (const char*)g.Bt + (size_t)cur.pn * tstep;
    S.a_ready(cur);
    if constexpr (SP2) {
        PG8_STAGE(PG8_SB(0, 0), cB, voffB); PG8_STAGE(PG8_SB(0, 1), cB + hstep, voffB); PG8_STAGE(PG8_SA(0, 0), cA, voffA); PG8_STAGE(PG8_SA(0, 1), cA + hstep, voffA);
        if (wr == 1) PG8_BAR;
        PG8_WAIT_V(2); PG8_BAR;
        PG8_STAGE(PG8_SB(1, 0), cB + kstep, voffB); PG8_STAGE(PG8_SA(1, 0), cA + kstep, voffA); PG8_STAGE(PG8_SB(1, 1), cB + hstep + kstep, voffB);
        PG8_WAIT_V(6); PG8_BAR;
    } else {
        PG8_STAGE(PG8_SB(0, 0), cB, voffB); PG8_STAGE(PG8_SA(0, 0), cA, voffA); PG8_STAGE(PG8_SB(0, 1), cB + hstep, voffB); PG8_STAGE(PG8_SA(0, 1), cA + hstep, voffA);
        if (wr == 1) PG8_BAR;
        PG8_WAIT_V(4); PG8_BAR;
        PG8_STAGE(PG8_SB(1, 0), cB + kstep, voffB); PG8_STAGE(PG8_SA(1, 0), cA + kstep, voffA); PG8_STAGE(PG8_SB(1, 1), cB + hstep + kstep, voffB);
        PG8_WAIT_V(6); PG8_BAR;
    }
    for (;;) {
        const bool has_next = S.next(ui + 1, nxt);
        const char* nA = has_next ? (const char*)g.A + (size_t)nxt.pm * tstep : cA; const char* nB = has_next ? (const char*)g.Bt + (size_t)nxt.pn * tstep : cB;
        for (int t = 0; t < nt; t += 2) {
            const bool last = (t == nt - 2);
            const char* a1 = cA + (size_t)(t + 1) * kstep;
            const char* a2 = last ? nA : cA + (size_t)(t + 2) * kstep; const char* b2 = last ? nB : cB + (size_t)(t + 2) * kstep;
            const char* a3 = a2 + kstep; const char* b3 = b2 + kstep;
            if (last && has_next) S.a_ready(nxt);
            if constexpr (SP2) {
            PG8_LDB(B0, 0, 0); PG8_LDB(B1, 0, 1); PG8_SCHED; PG8_LDA(At, 0, 0); PG8_STAGE(PG8_SA(1, 1), a1 + hstep, voffA);
            PG8_WAIT_V(8); PG8_WAIT_L(0); PG8_BAR; PG8_MMA(0, 0, At, B0); PG8_MMA(0, 1, At, B1); PG8_BAR; PG8_SCHED;
            PG8_LDA(At, 0, 1); PG8_STAGE(PG8_SB(0, 0), b2, voffB); PG8_STAGE(PG8_SB(0, 1), b2 + hstep, voffB); PG8_STAGE(PG8_SA(0, 0), a2, voffA);
            PG8_WAIT_V(8); PG8_WAIT_L(0); PG8_BAR; PG8_MMA(1, 0, At, B0); PG8_MMA(1, 1, At, B1); PG8_BAR; PG8_SCHED;
            PG8_LDB(B0, 1, 0); PG8_LDB(B1, 1, 1); PG8_SCHED; PG8_LDA(At, 1, 0); PG8_STAGE(PG8_SA(0, 1), a2 + hstep, voffA);
            PG8_WAIT_V(8); PG8_WAIT_L(0); PG8_BAR; PG8_MMA(0, 0, At, B0); PG8_MMA(0, 1, At, B1); PG8_BAR; PG8_SCHED;
            PG8_LDA(At, 1, 1); PG8_STAGE(PG8_SB(1, 0), b3, voffB); PG8_STAGE(PG8_SB(1, 1), b3 + hstep, voffB); PG8_STAGE(PG8_SA(1, 0), a3, voffA);
            PG8_WAIT_V(8); PG8_WAIT_L(0); PG8_BAR; PG8_MMA(1, 0, At, B0); PG8_MMA(1, 1, At, B1); PG8_BAR; PG8_SCHED;
            } else {
            PG8_LDB(B0, 0, 0); PG8_SCHED; PG8_LDA(At, 0, 0); PG8_STAGE(PG8_SA(1, 1), a1 + hstep, voffA);
            PG8_WAIT_L(8); PG8_BAR; PG8_WAIT_L(0); PG8_MMA(0, 0, At, B0); PG8_BAR; PG8_SCHED;
            PG8_LDB(B1, 0, 1); PG8_STAGE(PG8_SB(0, 0), b2, voffB);
            PG8_BAR; PG8_WAIT_L(0); PG8_MMA(0, 1, At, B1); PG8_BAR;
            PG8_LDA(At, 0, 1); PG8_STAGE(PG8_SA(0, 0), a2, voffA);
            PG8_BAR; PG8_WAIT_L(0); PG8_MMA(1, 0, At, B0); PG8_BAR; PG8_SCHED;
            PG8_STAGE(PG8_SB(0, 1), b2 + hstep, voffB);
            PG8_WAIT_V(6); PG8_BAR; PG8_MMA(1, 1, At, B1); PG8_BAR;
            PG8_LDB(B0, 1, 0); PG8_SCHED; PG8_LDA(At, 1, 0); PG8_STAGE(PG8_SA(0, 1), a2 + hstep, voffA);
            PG8_WAIT_L(8); PG8_BAR; PG8_WAIT_L(0); PG8_MMA(0, 0, At, B0); PG8_BAR; PG8_SCHED;
            PG8_LDB(B1, 1, 1); PG8_STAGE(PG8_SB(1, 0), b3, voffB);
            PG8_BAR; PG8_WAIT_L(0); PG8_MMA(0, 1, At, B1); PG8_BAR;
            PG8_LDA(At, 1, 1); PG8_STAGE(PG8_SA(1, 0), a3, voffA);
            PG8_BAR; PG8_WAIT_L(0); PG8_MMA(1, 0, At, B0); PG8_BAR; PG8_SCHED;
            PG8_STAGE(PG8_SB(1, 1), b3 + hstep, voffB);
            PG8_WAIT_V(6); PG8_BAR; PG8_MMA(1, 1, At, B1); PG8_BAR;
            }
        }
        if constexpr (ALIGN_EPI) { if (wr == 0) PG8_BAR; }
        if constexpr (!Epi::AFTER_DRAIN) { E(acc, cur, wr, wc, fr, fq); S.done(cur); }
        if (!has_next) break;
#pragma unroll
        for (int a = 0; a < 2; ++a)
#pragma unroll
            for (int b = 0; b < 2; ++b)
#pragma unroll
                for (int m = 0; m < 4; ++m)
#pragma unroll
                    for (int n = 0; n < 2; ++n) acc[a][b][m][n] = (f32x4){0.f, 0.f, 0.f, 0.f};
        cur = nxt; cA = nA; cB = nB; ++ui;
        if constexpr (ALIGN_EPI) { if (wr == 1) PG8_BAR; }
    }
    PG8_WAIT_V(0);
    if constexpr (!ALIGN_EPI) { if (wr == 0) PG8_BAR; }
    PG8_BAR;
    if constexpr (Epi::AFTER_DRAIN) { E.fused(acc, cur, wr, wc, fr, fq, lds, wid, lane); S.done(cur); }
#undef PG8_SA
#undef PG8_SB
#undef PG8_STAGE
#undef PG8_LDA
#undef PG8_LDB
#undef PG8_MMA
#undef PG8_WAIT_V
#undef PG8_WAIT_L
#undef PG8_BAR
#undef PG8_SCHED
}
}

namespace cg = cooperative_groups;
typedef unsigned short bf16;
typedef short bf16x8 __attribute__((ext_vector_type(8)));
typedef short s16x4 __attribute__((ext_vector_type(4)));
typedef float f32x4 __attribute__((ext_vector_type(4)));
typedef float f32x16 __attribute__((ext_vector_type(16)));
typedef unsigned u32x4 __attribute__((ext_vector_type(4)));
typedef unsigned u32x2 __attribute__((ext_vector_type(2)));
#define LAS __attribute__((address_space(3)))

constexpr int NB = 4, T = 8192, M = NB * T, D = 1024, FF = 4096;
constexpr int NIN = 3840;
constexpr float ALPHA = 1.41421356237309515f;
constexpr int LDS_BYTES = 147456;
constexpr int NSCAN = 64;

constexpr size_t MiB = 1u << 20;
constexpr size_t WS_WIN = 1 * MiB, WS_WOUT = 16 * MiB, WS_W1 = 20 * MiB, WS_W2 = 36 * MiB;
constexpr size_t WS_AB = 52 * MiB, WS_XN = 54 * MiB, WS_HZ = 118 * MiB, WS_HN = 150 * MiB, WS_HG = 246 * MiB;
constexpr size_t WS_RQ = 342 * MiB, WS_RK = 374 * MiB, WS_RV = 406 * MiB;
constexpr size_t WS_RTI = 438 * MiB, WS_RQK = 470 * MiB, WS_VEC = 502 * MiB;
constexpr size_t WS_HB = 150 * MiB;
constexpr size_t WS_YB = 406 * MiB;
constexpr size_t OUT_MIX = 64 * MiB;
constexpr size_t WS_END = 506 * MiB;

struct Params {
    const float *x, *ln_in_g, *ln_in_b, *w_in, *conv_w, *a_log, *dt_bias, *gdn_norm_g, *rpb, *na_norm_g, *w_out, *ln1_g, *ln1_b, *w1, *b1, *w2, *b2, *ln2_g, *ln2_b;
    float* out; unsigned char* ws;
};

typedef __bf16 bf16v2_t __attribute__((ext_vector_type(2)));
typedef float f32v2_t __attribute__((ext_vector_type(2)));
__device__ __forceinline__ unsigned pk2(float lo, float hi) { f32v2_t f = {lo, hi}; bf16v2_t b = __builtin_convertvector(f, bf16v2_t); return __builtin_bit_cast(unsigned, b); }
__device__ __forceinline__ unsigned short f2bf(float f) { return (unsigned short)(pk2(f, 0.f) & 0xffffu); }
__device__ __forceinline__ float bflo(unsigned u) { return __uint_as_float(u << 16); }
__device__ __forceinline__ float bfhi(unsigned u) { return __uint_as_float(u & 0xffff0000u); }
__device__ __forceinline__ int ppos(int o) { return (o & ~12) | ((o & 4) << 1) | ((o & 8) >> 1); }
__device__ __forceinline__ float wave_sum(float v) {
#pragma unroll
    for (int o = 1; o < 64; o <<= 1) v += __shfl_xor(v, o);
    return v;
}
__device__ __forceinline__ bf16x8 pack8(float a0, float a1, float a2, float a3, float a4, float a5, float a6, float a7) {
    u32x4 u; u.x = pk2(a0, a1); u.y = pk2(a2, a3); u.z = pk2(a4, a5); u.w = pk2(a6, a7);
    return __builtin_bit_cast(bf16x8, u);
}
#define MFMA32(a, b, c) __builtin_amdgcn_mfma_f32_32x32x16_bf16((a), (b), (c), 0, 0, 0)
#define MFMA16(a, b, c) __builtin_amdgcn_mfma_f32_16x16x32_bf16((a), (b), (c), 0, 0, 0)
typedef short v4i16_t __attribute__((ext_vector_type(4)));
__device__ __forceinline__ s16x4 trread(const LAS bf16* p) { return __builtin_bit_cast(s16x4, __builtin_amdgcn_ds_read_tr16_b64_v4i16((LAS v4i16_t*)p)); }
__device__ __forceinline__ bf16x8 cat8(s16x4 lo, s16x4 hi) { bf16x8 r; r[0] = lo[0]; r[1] = lo[1]; r[2] = lo[2]; r[3] = lo[3]; r[4] = hi[0]; r[5] = hi[1]; r[6] = hi[2]; r[7] = hi[3]; return r; }
#define LDS_BARRIER() do { asm volatile("s_waitcnt lgkmcnt(0)" ::: "memory"); __builtin_amdgcn_s_barrier(); asm volatile("" ::: "memory"); } while (0)
#define SBAR __builtin_amdgcn_sched_barrier(0)
#define WAVE_SYNC() do { __builtin_amdgcn_fence(__ATOMIC_RELEASE, "wavefront"); __builtin_amdgcn_wave_barrier(); __builtin_amdgcn_fence(__ATOMIC_ACQUIRE, "wavefront"); } while (0)

__device__ __forceinline__ int otid() { int t = threadIdx.x; asm volatile("" : "+v"(t)); return t; }
__device__ __forceinline__ int obid() { int t = blockIdx.x; asm volatile("" : "+s"(t)); return t; }

struct EpiIn {
    static constexpr bool PERM = true, AFTER_DRAIN = false;
    bf16 *HG, *HZ, *HN; float* AB; int pn_off;
    __device__ __forceinline__ void operator()(const f32x4 (&acc)[2][2][4][2], const pg8::Unit& u, int wr, int wc, int fr, int fq) const {
        const int row0 = u.pm * 256 + wr * 64 + fr;
        const int pn = u.pn + pn_off;
        if (pn != 12) {
            bf16* base; int ldc, colt;
            if (pn < 6) { base = HG; ldc = 1536; colt = pn * 256; }
            else if (pn < 12) { base = HN; ldc = 1536; colt = (pn - 6) * 256; }
            else { base = HZ; ldc = 512; colt = (pn - 13) * 256; }
            const int col0 = colt + wc * 32 + 8 * fq;
#pragma unroll
            for (int ai = 0; ai < 2; ++ai)
#pragma unroll
                for (int m = 0; m < 4; ++m) {
                    bf16* rowp = base + (size_t)(row0 + ai * 128 + m * 16) * ldc + col0;
#pragma unroll
                    for (int bj = 0; bj < 2; ++bj) {
                        const f32x4 v0 = acc[ai][bj][m][0], v1 = acc[ai][bj][m][1];
                        u32x4 w; w.x = pk2(v0[0], v0[1]); w.y = pk2(v0[2], v0[3]); w.z = pk2(v1[0], v1[1]); w.w = pk2(v1[2], v1[3]);
                        *(u32x4*)(rowp + bj * 128) = w;
                    }
                }
        } else {
            if (wc == 0 && fq < 2) {
#pragma unroll
                for (int ai = 0; ai < 2; ++ai)
#pragma unroll
                    for (int m = 0; m < 4; ++m) {
                        float* rp = AB + (size_t)(row0 + ai * 128 + m * 16) * 16 + 8 * fq;
                        *(f32x4*)(rp) = acc[ai][0][m][0];
                        *(f32x4*)(rp + 4) = acc[ai][0][m][1];
                    }
            }
        }
    }
};
struct EpiUp {
    static constexpr bool PERM = true, AFTER_DRAIN = false;
    bf16* O; const float* bias;
    __device__ __forceinline__ void operator()(const f32x4 (&acc)[2][2][4][2], const pg8::Unit& u, int wr, int wc, int fr, int fq) const {
        const int row0 = u.pm * 256 + wr * 64 + fr;
        const int col0 = u.pn * 256 + wc * 32 + 8 * fq;
        f32x4 bv[2][2];
#pragma unroll
        for (int bj = 0; bj < 2; ++bj)
#pragma unroll
            for (int n = 0; n < 2; ++n) bv[bj][n] = *(const f32x4*)(bias + col0 + bj * 128 + 4 * n);
#pragma unroll
        for (int ai = 0; ai < 2; ++ai)
#pragma unroll
            for (int m = 0; m < 4; ++m) {
                bf16* rowp = O + (size_t)(row0 + ai * 128 + m * 16) * FF + col0;
#pragma unroll
                for (int bj = 0; bj < 2; ++bj) {
                    f32x4 v0 = acc[ai][bj][m][0] + bv[bj][0], v1 = acc[ai][bj][m][1] + bv[bj][1];
#pragma unroll
                    for (int e = 0; e < 4; ++e) { const float a = fmaxf(v0[e], 0.f), b = fmaxf(v1[e], 0.f); v0[e] = a * a; v1[e] = b * b; }
                    u32x4 w; w.x = pk2(v0[0], v0[1]); w.y = pk2(v0[2], v0[3]); w.z = pk2(v1[0], v1[1]); w.w = pk2(v1[2], v1[3]);
                    *(u32x4*)(rowp + bj * 128) = w;
                }
            }
    }
};
struct EpiRes {
    static constexpr bool PERM = true, AFTER_DRAIN = false;
    const bf16* XR; bf16* Y; const float* bias;
    __device__ __forceinline__ void operator()(const f32x4 (&acc)[2][2][4][2], const pg8::Unit& u, int wr, int wc, int fr, int fq) const {
        const int row0 = u.pm * 256 + wr * 64 + fr;
        const int col0 = u.pn * 256 + wc * 32 + 8 * fq;
#pragma unroll
        for (int ai = 0; ai < 2; ++ai)
#pragma unroll
            for (int m = 0; m < 4; ++m) {
                const size_t off = (size_t)(row0 + ai * 128 + m * 16) * D + col0;
#pragma unroll
                for (int bj = 0; bj < 2; ++bj) {
                    const u32x4 xr = *(const u32x4*)(XR + off + bj * 128);
                    f32x4 b0 = {0.f, 0.f, 0.f, 0.f}, b1 = {0.f, 0.f, 0.f, 0.f};
                    if (bias) { b0 = *(const f32x4*)(bias + col0 + bj * 128); b1 = *(const f32x4*)(bias + col0 + bj * 128 + 4); }
                    const f32x4 v0 = acc[ai][bj][m][0] + b0, v1 = acc[ai][bj][m][1] + b1;
                    u32x4 w;
                    w.x = pk2(ALPHA * bflo(xr.x) + v0[0], ALPHA * bfhi(xr.x) + v0[1]); w.y = pk2(ALPHA * bflo(xr.y) + v0[2], ALPHA * bfhi(xr.y) + v0[3]);
                    w.z = pk2(ALPHA * bflo(xr.z) + v1[0], ALPHA * bfhi(xr.z) + v1[1]); w.w = pk2(ALPHA * bflo(xr.w) + v1[2], ALPHA * bfhi(xr.w) + v1[3]);
                    *(u32x4*)(Y + off + bj * 128) = w;
                }
            }
    }
};

__device__ __forceinline__ void tr_item(const float* W, int ld, int K, int src_col0, int nvalid, bf16* WT, int dst_row0, LAS float* scr, int kb, int nb, int lane) {
    const int k0 = 64 * kb, n0 = 32 * nb;
    const int nq = (lane & 7) * 4, n = n0 + nq;
#pragma unroll
    for (int i = 0; i < 8; ++i) {
        const int kk = 8 * i + (lane >> 3);
        f32x4 v = {0.f, 0.f, 0.f, 0.f};
        if (n < nvalid) v = *(const f32x4*)(W + (size_t)(k0 + kk) * ld + src_col0 + n);
        scr[kk * 33 + nq + 0] = v[0]; scr[kk * 33 + nq + 1] = v[1]; scr[kk * 33 + nq + 2] = v[2]; scr[kk * 33 + nq + 3] = v[3];
    }
    WAVE_SYNC();
    const int c = lane & 7;
#pragma unroll
    for (int j = 0; j < 4; ++j) {
        const int nn = (lane >> 3) + 8 * j; const LAS float* s = scr + (8 * c) * 33 + nn;
        u32x4 o; o.x = pk2(s[0 * 33], s[1 * 33]); o.y = pk2(s[2 * 33], s[3 * 33]); o.z = pk2(s[4 * 33], s[5 * 33]); o.w = pk2(s[6 * 33], s[7 * 33]);
        *(u32x4*)(WT + (size_t)(dst_row0 + n0 + nn) * K + k0 + 8 * c) = o;
    }
    WAVE_SYNC();
}
__device__ __forceinline__ void ln_row(const float* src, float* dstf, bf16* dstb, const float* g, const float* b, int lane) {
    f32x4 v[4]; float s = 0.f;
#pragma unroll
    for (int j = 0; j < 4; ++j) { v[j] = *(const f32x4*)(src + 4 * lane + 256 * j); s += (v[j][0] + v[j][1]) + (v[j][2] + v[j][3]); }
    const float mean = wave_sum(s) * (1.f / D); float s2 = 0.f;
#pragma unroll
    for (int j = 0; j < 4; ++j) { v[j] = v[j] - mean; s2 += (v[j][0] * v[j][0] + v[j][1] * v[j][1]) + (v[j][2] * v[j][2] + v[j][3] * v[j][3]); }
    const float rstd = 1.0f / sqrtf(wave_sum(s2) * (1.f / D) + 1e-5f);
#pragma unroll
    for (int j = 0; j < 4; ++j) {
        const f32x4 gv = *(const f32x4*)(g + 4 * lane + 256 * j), bv = *(const f32x4*)(b + 4 * lane + 256 * j);
        const f32x4 y = v[j] * rstd * gv + bv;
        if (dstf) *(f32x4*)(dstf + 4 * lane + 256 * j) = y;
        if (dstb) { u32x2 w; w.x = pk2(y[0], y[1]); w.y = pk2(y[2], y[3]); *(u32x2*)(dstb + 4 * lane + 256 * j) = w; }
    }
}
__device__ __forceinline__ void ln_row_b(const bf16* src, float* dstf, bf16* dstb, const float* g, const float* b, int lane) {
    float v[16]; float s = 0.f;
#pragma unroll
    for (int j = 0; j < 2; ++j) {
        const u32x4 u = *(const u32x4*)(src + 8 * lane + 512 * j);
#pragma unroll
        for (int k = 0; k < 4; ++k) { v[8 * j + 2 * k] = bflo(u[k]); v[8 * j + 2 * k + 1] = bfhi(u[k]); }
    }
#pragma unroll
    for (int k = 0; k < 16; ++k) s += v[k];
    const float mean = wave_sum(s) * (1.f / D); float s2 = 0.f;
#pragma unroll
    for (int k = 0; k < 16; ++k) { v[k] -= mean; s2 += v[k] * v[k]; }
    const float rstd = 1.0f / sqrtf(wave_sum(s2) * (1.f / D) + 1e-5f);
#pragma unroll
    for (int j = 0; j < 2; ++j) {
        const f32x4 g0 = *(const f32x4*)(g + 8 * lane + 512 * j), g1 = *(const f32x4*)(g + 8 * lane + 512 * j + 4);
        const f32x4 b0 = *(const f32x4*)(b + 8 * lane + 512 * j), b1 = *(const f32x4*)(b + 8 * lane + 512 * j + 4);
        f32x4 y0, y1;
#pragma unroll
        for (int k = 0; k < 4; ++k) { y0[k] = v[8 * j + k] * rstd * g0[k] + b0[k]; y1[k] = v[8 * j + 4 + k] * rstd * g1[k] + b1[k]; }
        if (dstf) { *(f32x4*)(dstf + 8 * lane + 512 * j) = y0; *(f32x4*)(dstf + 8 * lane + 512 * j + 4) = y1; }
        if (dstb) { u32x4 w; w.x = pk2(y0[0], y0[1]); w.y = pk2(y0[2], y0[3]); w.z = pk2(y1[0], y1[1]); w.w = pk2(y1[2], y1[3]); *(u32x4*)(dstb + 8 * lane + 512 * j) = w; }
    }
}
__device__ __forceinline__ void ln_phase_b(const bf16* src, float* dstf, bf16* dstb, const float* g, const float* b) {
    const int lane = otid() & 63, gw = obid() * 8 + (otid() >> 6), ngw = gridDim.x * 8;
    for (int m = gw; m < M; m += ngw) ln_row_b(src + (size_t)m * D, dstf ? dstf + (size_t)m * D : nullptr, dstb ? dstb + (size_t)m * D : nullptr, g, b, lane);
}
__device__ __forceinline__ void ln_phase(const float* src, float* dstf, bf16* dstb, const float* g, const float* b) {
    const int lane = otid() & 63, gw = obid() * 8 + (otid() >> 6), ngw = gridDim.x * 8;
    for (int m = gw; m < M; m += ngw) ln_row(src + (size_t)m * D, dstf ? dstf + (size_t)m * D : nullptr, dstb ? dstb + (size_t)m * D : nullptr, g, b, lane);
}
__device__ __forceinline__ void convert_weights(const Params& p, int l, LAS float* scr, int gw, int ngw, int lane, int part) {
    constexpr int I_A = 48 * 16, I_B = 48 * 16, I_C = 8 * 16, I_Z = 16 * 16, I_O = 32 * 16, I_1 = 128 * 16, I_2 = 32 * 64;
    constexpr int PER_L = I_A + I_B + I_C + I_Z + I_O + I_1 + I_2;
    const float* win = p.w_in + (size_t)l * D * 3600;
    bf16* winT = (bf16*)(p.ws + WS_WIN) + (size_t)l * NIN * D;
    const int lo = (part & 1) ? 0 : (I_A + I_B + I_C + I_Z), hi = (part & 2) ? PER_L : (I_A + I_B + I_C + I_Z);
    for (int it = lo + gw; it < hi; it += ngw) {
        int r = it;
        if (r < I_A) { tr_item(win, 3600, D, 0, 1536, winT, 0, scr, r / 48, r % 48, lane); continue; } r -= I_A;
        if (r < I_B) { tr_item(win, 3600, D, 2064, 1536, winT, 1536, scr, r / 48, r % 48, lane); continue; } r -= I_B;
        if (r < I_C) { tr_item(win, 3600, D, 2048, 16, winT, 3072, scr, r / 8, r % 8, lane); continue; } r -= I_C;
        if (r < I_Z) { tr_item(win, 3600, D, 1536, 512, winT, 3328, scr, r / 16, r % 16, lane); continue; } r -= I_Z;
        if (r < I_O) { tr_item(p.w_out + (size_t)l * D * D, D, D, 0, D, (bf16*)(p.ws + WS_WOUT) + (size_t)l * D * D, 0, scr, r / 32, r % 32, lane); continue; } r -= I_O;
        if (r < I_1) { tr_item(p.w1 + (size_t)l * D * FF, FF, D, 0, FF, (bf16*)(p.ws + WS_W1) + (size_t)l * D * FF, 0, scr, r / 128, r % 128, lane); continue; } r -= I_1;
        tr_item(p.w2 + (size_t)l * D * FF, D, FF, 0, D, (bf16*)(p.ws + WS_W2) + (size_t)l * D * FF, 0, scr, r / 32, r % 32, lane);
    }
}
__device__ __forceinline__ void phase0(const Params& p, LAS unsigned char* lds) {
    const int lane = otid() & 63, w = otid() >> 6, gw = obid() * 8 + w, ngw = gridDim.x * 8;
    convert_weights(p, 0, (LAS float*)(lds + w * 16384), gw, ngw, lane, 1);
    ln_phase(p.x, nullptr, (bf16*)(p.ws + WS_XN), p.ln_in_g, p.ln_in_b);
}

__device__ __forceinline__ void ab_phase(unsigned char* ws, size_t woff) {
    const int lane = otid() & 63, grp = obid() * 8 + (otid() >> 6);
    if (grp < M / 16) {
        const bf16* wb = (const bf16*)(ws + woff) + (size_t)(lane & 15) * D + 8 * (lane >> 4);
        const bf16* xa = (const bf16*)(ws + WS_XN) + (size_t)(16 * grp + (lane & 15)) * D + 8 * (lane >> 4);
        f32x4 acc = {0.f, 0.f, 0.f, 0.f};
#pragma unroll 1
        for (int k8 = 0; k8 < 4; ++k8) {
            bf16x8 a[8], b[8];
#pragma unroll
            for (int j = 0; j < 8; ++j) { a[j] = *(const bf16x8*)(xa + 32 * (8 * k8 + j)); b[j] = *(const bf16x8*)(wb + 32 * (8 * k8 + j)); }
#pragma unroll
            for (int j = 0; j < 8; ++j) acc = MFMA16(a[j], b[j], acc);
        }
        float* AB = (float*)(ws + WS_AB) + (size_t)(16 * grp + 4 * (lane >> 4)) * 16 + (lane & 15);
        AB[0] = acc[0]; AB[16] = acc[1]; AB[32] = acc[2]; AB[48] = acc[3];
    }
}
__device__ __forceinline__ void prep_phase(const Params& p, int layer, LAS unsigned char* lds, int mode = 7) {
    const int tid = otid(), lane = tid & 63, w = tid >> 6;
    LAS bf16* Qs = (LAS bf16*)lds;
    LAS bf16* Ks = Qs + 64 * 136;
    LAS bf16* Vs = Ks + 64 * 136;
    LAS float* gcs = (LAS float*)(lds + 3 * 64 * 136 * 2);
    LAS float* bts = gcs + 128;
    const float* convw = p.conv_w + (size_t)layer * 5 * 1536;
    const bf16* HG = (const bf16*)(p.ws + WS_HG);
    const float* AB = (const float*)(p.ws + WS_AB);
    float* Amat = (float*)((unsigned char*)p.out + OUT_MIX);
    bf16* recq = (bf16*)(p.ws + WS_RQ); bf16* reck = (bf16*)(p.ws + WS_RK); bf16* recv = (bf16*)(p.ws + WS_RV);
    bf16* recti = (bf16*)(p.ws + WS_RTI); bf16* recqk = (bf16*)(p.ws + WS_RQK); float* recvec = (float*)(p.ws + WS_VEC);
    int nit = 0;
    for (int item = obid(); item < 2048; item += gridDim.x, ++nit) {
        if (!(mode & 5)) continue;
        const int b = item >> 9, h = (item >> 7) & 3, n = item & 127;
        const int m0 = b * T + 64 * n;
        if (mode & 1) {
        if (w < 2) {
            const int dir = w, r = lane, c = dir ? 63 - r : r, m = m0 + c;
            const float a = AB[(size_t)m * 16 + dir * 4 + h], bb = AB[(size_t)m * 16 + 8 + dir * 4 + h];
            const float Aa = expf(p.a_log[layer * 8 + dir * 4 + h]);
            const float xx = a + p.dt_bias[layer * 8 + dir * 4 + h];
            const float sp = xx > 20.f ? xx : log1pf(expf(xx));
            const float g = -Aa * sp, beta = 1.f / (1.f + expf(-bb));
            float gc = g;
#pragma unroll
            for (int o = 1; o < 64; o <<= 1) { const float t = __shfl_up(gc, o); if (lane >= o) gc += t; }
            const float gl = __shfl(gc, 63);
            gcs[dir * 64 + r] = gc; bts[dir * 64 + r] = beta;
            float* vec = recvec + (size_t)(item * 2 + dir) * 256;
            vec[r] = expf(gc); vec[64 + r] = beta; vec[128 + r] = expf(gl - gc); if (r == 0) vec[192] = expf(gl);
        }
#pragma unroll
        for (int s = 0; s < 3; ++s) {
            const int col = s * 512 + h * 128 + 2 * lane;
            float w0[5], w1[5];
#pragma unroll
            for (int i = 0; i < 5; ++i) { w0[i] = convw[i * 1536 + col]; w1[i] = convw[i * 1536 + col + 1]; }
            float x0[12], x1[12];
#pragma unroll
            for (int i = 0; i < 12; ++i) {
                const int tl = 64 * n + 8 * w - 2 + i;
                unsigned u = 0u;
                if (tl >= 0 && tl < T) u = *(const unsigned*)(HG + (size_t)(b * T + tl) * 1536 + col);
                x0[i] = bflo(u); x1[i] = bfhi(u);
            }
            LAS bf16* dst = (s == 0) ? Qs : (s == 1 ? Ks : Vs);
            const int pos = (s < 2) ? ppos(2 * lane) : 2 * lane;
#pragma unroll
            for (int c8 = 0; c8 < 8; ++c8) {
                float y0 = 0.f, y1 = 0.f;
#pragma unroll
                for (int i = 0; i < 5; ++i) { y0 += w0[i] * x0[c8 + i]; y1 += w1[i] * x1[c8 + i]; }
                y0 = y0 * __builtin_amdgcn_rcpf(1.f + __expf(-y0)); y1 = y1 * __builtin_amdgcn_rcpf(1.f + __expf(-y1));
                if (s < 2) {
                    const float ss = wave_sum(y0 * y0 + y1 * y1);
                    float inv = __builtin_amdgcn_rsqf(ss + 1e-6f);
                    if (s == 0) inv *= 0.08838834764831845f;
                    y0 *= inv; y1 *= inv;
                }
                *(LAS unsigned*)(dst + (8 * w + c8) * 136 + pos) = pk2(y0, y1);
            }
        }
        }
        LDS_BARRIER();
        if (mode & 4) {
        {
            bf16* qr = recq + (size_t)item * 8192; bf16* kr = reck + (size_t)item * 8192; bf16* vr = recv + (size_t)item * 8192;
            for (int ch = tid; ch < 1024; ch += 512) {
                const int r = ch >> 4, cc = ch & 15;
                *(u32x4*)(qr + r * 128 + cc * 8) = *(const LAS u32x4*)(Qs + r * 136 + cc * 8);
                *(u32x4*)(kr + r * 128 + cc * 8) = *(const LAS u32x4*)(Ks + r * 136 + cc * 8);
            }
            const int v = tid & 127;
            for (int cgp = tid >> 7; cgp < 8; cgp += 4) {
                const int c0 = 8 * cgp; unsigned short e[8];
#pragma unroll
                for (int k = 0; k < 8; ++k) e[k] = Vs[(c0 + k) * 136 + v];
                u32x4 o; o.x = e[0] | ((unsigned)e[1] << 16); o.y = e[2] | ((unsigned)e[3] << 16); o.z = e[4] | ((unsigned)e[5] << 16); o.w = e[6] | ((unsigned)e[7] << 16);
                *(u32x4*)(vr + v * 64 + c0) = o;
            }
        }
        {
            int lo_ = lane; asm volatile("" : "+v"(lo_));
            const int mat = w >> 2, ti = (w >> 1) & 1, tj = w & 1, l31 = lo_ & 31, h2 = lo_ >> 5;
            const LAS bf16* X = mat ? Qs : Ks;
            f32x16 acc;
#pragma unroll
            for (int r = 0; r < 16; ++r) acc[r] = 0.f;
#pragma unroll
            for (int s = 0; s < 8; ++s) {
                const bf16x8 a = *(const LAS bf16x8*)(Ks + (32 * tj + l31) * 136 + 16 * s + 8 * h2);
                const bf16x8 bb = *(const LAS bf16x8*)(X + (32 * ti + l31) * 136 + 16 * s + 8 * h2);
                acc = MFMA32(a, bb, acc);
            }
            const int i = 32 * ti + l31;
#pragma unroll
            for (int dir = 0; dir < 2; ++dir) {
                const int ri = dir ? 63 - i : i; const float gci = gcs[dir * 64 + ri], bti = bts[dir * 64 + ri];
                const size_t id = (size_t)(item * 2 + dir);
#pragma unroll
                for (int q = 0; q < 4; ++q) {
                    const int j0 = 32 * tj + 8 * q + 4 * h2;
                    const int rj0 = dir ? 60 - j0 : j0;
                    const f32x4 gq = *(const LAS f32x4*)(gcs + dir * 64 + rj0);
                    f32x4 val;
#pragma unroll
                    for (int e = 0; e < 4; ++e) {
                        const int rj = rj0 + e;
                        const float a = acc[4 * q + (dir ? 3 - e : e)];
                        const float ex = __expf(fminf(gci - gq[e], 0.f));
                        val[e] = (mat == 0) ? ((rj < ri) ? bti * a * ex : 0.f) : ((rj <= ri) ? a * ex : 0.f);
                    }
                    if (mat == 0) *(f32x4*)(Amat + id * 4096 + ri * 64 + rj0) = val;
                    else { u32x2 wv; wv.x = pk2(val[0], val[1]); wv.y = pk2(val[2], val[3]); *(u32x2*)(recqk + id * 4096 + ri * 64 + ppos(rj0)) = wv; }
                }
            }
        }
        }
        LDS_BARRIER();
    }
    __syncthreads();
    {

        for (int sidx = w; sidx < ((mode & 2) ? 2 * nit : 0); sidx += 8) {
            const int item = obid() + (sidx >> 1) * gridDim.x, dir = sidx & 1;
            const size_t id = (size_t)(item * 2 + dir);
            const float* Ag = Amat + id * 4096;
            float x[64];
            const float lanef = (float)lane;
            float rowv[8];
#pragma unroll
            for (int q = 0; q < 8; ++q) rowv[q] = Ag[q * 64 + lane];
#pragma unroll
            for (int i = 0; i < 64; ++i) {
                const float rv = rowv[i & 7];
                if (i + 8 < 64) rowv[i & 7] = Ag[(i + 8) * 64 + lane];
                float a0 = fmaxf(1.f - fabsf(lanef - (float)i), 0.f), a1 = 0.f, a2 = 0.f, a3 = 0.f;
#pragma unroll
                for (int j = 0; j < i; ++j) {
                    const float s = __builtin_bit_cast(float, __builtin_amdgcn_readlane(__builtin_bit_cast(int, rv), j));
                    if ((j & 3) == 0) a0 = fmaf(-s, x[j], a0); else if ((j & 3) == 1) a1 = fmaf(-s, x[j], a1); else if ((j & 3) == 2) a2 = fmaf(-s, x[j], a2); else a3 = fmaf(-s, x[j], a3);
                }
                x[i] = (a0 + a1) + (a2 + a3);
            }
            bf16* tr = recti + id * 4096; const int pos = ppos(lane);
#pragma unroll
            for (int i = 0; i < 64; ++i) tr[i * 64 + pos] = f2bf(x[i]);
        }
    }
}

constexpr int SC_BUF = 72704, SC_Q = 0, SC_K = 17408, SC_TI = 34816, SC_QK = 44032, SC_VEC = 53248, SC_V = 54272;
struct ScanRegs { u32x4 rq[4], rk[4], rt[2], rqk[2], rvv[4]; float rv; };
template <int dir> __device__ __forceinline__ void scan_fetch(const Params& p, int b, int h, int n, int lt, ScanRegs& R) {
    const int nt = dir ? 127 - n : n; const size_t item = (size_t)((b * 4 + h) * 128 + nt); const size_t id = item * 2 + dir;
    const bf16* qr = (const bf16*)(p.ws + WS_RQ) + item * 8192; const bf16* kr = (const bf16*)(p.ws + WS_RK) + item * 8192;
    const bf16* tr = (const bf16*)(p.ws + WS_RTI) + id * 4096; const bf16* qk = (const bf16*)(p.ws + WS_RQK) + id * 4096;
    const float* vec = (const float*)(p.ws + WS_VEC) + id * 256;
    const bf16* vt = (const bf16*)(p.ws + WS_RV) + item * 8192;
#pragma unroll
    for (int i = 0; i < 4; ++i) { const int ch = lt + 256 * i; R.rvv[i] = *(const u32x4*)(vt + ch * 8); }
#pragma unroll
    for (int i = 0; i < 4; ++i) { const int ch = lt + 256 * i, r = ch >> 4, cc = ch & 15, sr = dir ? 63 - r : r; R.rq[i] = *(const u32x4*)(qr + sr * 128 + cc * 8); R.rk[i] = *(const u32x4*)(kr + sr * 128 + cc * 8); }
#pragma unroll
    for (int i = 0; i < 2; ++i) { const int ch = lt + 256 * i, r = ch >> 3, cc = ch & 7; R.rt[i] = *(const u32x4*)(tr + r * 64 + cc * 8); R.rqk[i] = *(const u32x4*)(qk + r * 64 + cc * 8); }
    R.rv = (lt < 193) ? vec[lt] : 0.f;
}
__device__ __forceinline__ void scan_store(LAS unsigned char* buf, int lt, const ScanRegs& R) {
#pragma unroll
    for (int i = 0; i < 4; ++i) { const int ch = lt + 256 * i, r = ch >> 4, cc = ch & 15; *(LAS u32x4*)(buf + SC_Q + (r * 136 + cc * 8) * 2) = R.rq[i]; *(LAS u32x4*)(buf + SC_K + (r * 136 + cc * 8) * 2) = R.rk[i]; }
#pragma unroll
    for (int i = 0; i < 2; ++i) { const int ch = lt + 256 * i, r = ch >> 3, cc = ch & 7; *(LAS u32x4*)(buf + SC_TI + (r * 72 + cc * 8) * 2) = R.rt[i]; *(LAS u32x4*)(buf + SC_QK + (r * 72 + cc * 8) * 2) = R.rqk[i]; }
    *(LAS float*)(buf + SC_VEC + lt * 4) = R.rv;
#pragma unroll
    for (int i = 0; i < 4; ++i) { const int ch = lt + 256 * i, v = ch >> 3, cc = ch & 7; *(LAS u32x4*)(buf + SC_V + v * 144 + cc * 16) = R.rvv[i]; }
}
template <int dir, int smode = 7> __device__ __forceinline__ void scan_chain(const Params& p, int layer, LAS unsigned char* lds, int chain) {
    const int tid = otid(), lane = tid & 63, w = __builtin_amdgcn_readfirstlane(tid >> 6);
    const int half = chain & 1; chain >>= 1;
    const int b = chain >> 3, h = (chain >> 1) & 3;
    const int l31 = lane & 31, h2 = lane >> 5, vcol = 64 * half + 32 * (w & 1) + l31;
    bf16* og = (bf16*)(p.ws + WS_HG) + (size_t)dir * M * 512;
    if (w >= 4) {
        if (!(smode & 1)) { LDS_BARRIER(); for (int n = 0; n < 128; ++n) LDS_BARRIER(); return; }
        ScanRegs R0, R1;
        scan_fetch<dir>(p, b, h, 0, tid - 256, R0); scan_store(lds, tid - 256, R0); scan_fetch<dir>(p, b, h, 1, tid - 256, R0); scan_fetch<dir>(p, b, h, 2, tid - 256, R1);
        LDS_BARRIER();
#pragma unroll 1
        for (int n = 0; n < 128; n += 2) {
            scan_store(lds + SC_BUF, tid - 256, R0);
            if (n + 3 < 128) scan_fetch<dir>(p, b, h, n + 3, tid - 256, R0);
            LDS_BARRIER();
            if (n + 2 < 128) scan_store(lds, tid - 256, R1);
            if (n + 4 < 128) scan_fetch<dir>(p, b, h, n + 4, tid - 256, R1);
            LDS_BARRIER();
        }
    } else if (w >= 2) {
        LDS_BARRIER();
#pragma unroll 1
        for (int n = 0; n < 128; ++n) LDS_BARRIER();
    } else {
        if (!(smode & 2)) { LDS_BARRIER(); for (int n = 0; n < 128; ++n) LDS_BARRIER(); return; }
        f32x16 S[4];
#pragma unroll
        for (int k = 0; k < 4; ++k)
#pragma unroll
            for (int r = 0; r < 16; ++r) S[k][r] = 0.f;
        LDS_BARRIER();
#pragma unroll 1
        for (int n = 0; n < 128; ++n) {
            const LAS unsigned char* buf = lds + (n & 1) * SC_BUF;
            const LAS bf16* Qp = (const LAS bf16*)(buf + SC_Q); const LAS bf16* Kp = (const LAS bf16*)(buf + SC_K);
            const LAS bf16* Ti = (const LAS bf16*)(buf + SC_TI); const LAS bf16* QKm = (const LAS bf16*)(buf + SC_QK);
            const LAS float* vecl = (const LAS float*)(buf + SC_VEC);
            const float gl = vecl[192];
            bf16x8 Sb[8];
#pragma unroll
            for (int kt = 0; kt < 4; ++kt)
#pragma unroll
                for (int s = 0; s < 2; ++s) Sb[2 * kt + s] = pack8(S[kt][8 * s + 0], S[kt][8 * s + 1], S[kt][8 * s + 2], S[kt][8 * s + 3], S[kt][8 * s + 4], S[kt][8 * s + 5], S[kt][8 * s + 6], S[kt][8 * s + 7]);
            SBAR;
            f32x16 kA, kB;
#pragma unroll
            for (int r = 0; r < 16; ++r) { kA[r] = 0.f; kB[r] = 0.f; }
#pragma unroll
            for (int hf = 0; hf < 2; ++hf) {
                bf16x8 f0[4], f1[4];
#pragma unroll
                for (int k4 = 0; k4 < 4; ++k4) {
                    f0[k4] = *(const LAS bf16x8*)(Kp + (l31) * 136 + 16 * (4 * hf + k4) + 8 * h2);
                    f1[k4] = *(const LAS bf16x8*)(Kp + (32 + l31) * 136 + 16 * (4 * hf + k4) + 8 * h2);
                }
                SBAR;
#pragma unroll
                for (int k4 = 0; k4 < 4; ++k4) { kA = MFMA32(f0[k4], Sb[4 * hf + k4], kA); kB = MFMA32(f1[k4], Sb[4 * hf + k4], kB); }
                SBAR;
            }
            f32x16 qA, qB;
#pragma unroll
            for (int r = 0; r < 16; ++r) { qA[r] = 0.f; qB[r] = 0.f; }
            bf16x8 tb[4];
#pragma unroll
            for (int pt = 0; pt < 4; ++pt) {
                const int mt = pt >> 1, s = pt & 1;
                bf16x8 f0[2], f1[2];
#pragma unroll
                for (int k2 = 0; k2 < 2; ++k2) {
                    f0[k2] = *(const LAS bf16x8*)(Qp + (l31) * 136 + 16 * (2 * pt + k2) + 8 * h2);
                    f1[k2] = *(const LAS bf16x8*)(Qp + (32 + l31) * 136 + 16 * (2 * pt + k2) + 8 * h2);
                }
                f32x4 eg[2], bt[2]; u32x2 vq[2];
#pragma unroll
                for (int qq = 0; qq < 2; ++qq) {
                    const int q = 2 * s + qq;
                    eg[qq] = *(const LAS f32x4*)(vecl + 32 * mt + 8 * q + 4 * h2); bt[qq] = *(const LAS f32x4*)(vecl + 64 + 32 * mt + 8 * q + 4 * h2);
                    vq[qq] = *(const LAS u32x2*)(buf + SC_V + vcol * 144 + (dir ? 60 - (32 * mt + 8 * q + 4 * h2) : (32 * mt + 8 * q + 4 * h2)) * 2);
                }
                SBAR;
#pragma unroll
                for (int k2 = 0; k2 < 2; ++k2) { qA = MFMA32(f0[k2], Sb[2 * pt + k2], qA); qB = MFMA32(f1[k2], Sb[2 * pt + k2], qB); }
                float t8[8];
#pragma unroll
                for (int qq = 0; qq < 2; ++qq) {
                    const u32x2 u = vq[qq];
                    const float e0 = bflo(u.x), e1 = bfhi(u.x), e2 = bflo(u.y), e3 = bfhi(u.y);
                    f32x4 vv; vv[0] = dir ? e3 : e0; vv[1] = dir ? e2 : e1; vv[2] = dir ? e1 : e2; vv[3] = dir ? e0 : e3;
#pragma unroll
                    for (int e = 0; e < 4; ++e) { const float ksv = mt ? kB[8 * s + 4 * qq + e] : kA[8 * s + 4 * qq + e]; t8[4 * qq + e] = bt[qq][e] * (vv[e] - eg[qq][e] * ksv); }
                }
                tb[pt] = pack8(t8[0], t8[1], t8[2], t8[3], t8[4], t8[5], t8[6], t8[7]);
#pragma unroll
                for (int g = 0; g < 4; ++g) { __builtin_amdgcn_sched_group_barrier(0x8, 1, 0); __builtin_amdgcn_sched_group_barrier(0x2, 9, 0); }
                SBAR;
            }
            f32x16 vA, vB;
#pragma unroll
            for (int r = 0; r < 16; ++r) { vA[r] = 0.f; vB[r] = 0.f; }
            {
                bf16x8 f0[4], f1[4];
#pragma unroll
                for (int ks = 0; ks < 4; ++ks) {
                    f0[ks] = *(const LAS bf16x8*)(Ti + (l31) * 72 + 16 * ks + 8 * h2);
                    f1[ks] = *(const LAS bf16x8*)(Ti + (32 + l31) * 72 + 16 * ks + 8 * h2);
                }
                f32x4 egA[4], egB[4];
#pragma unroll
                for (int q = 0; q < 4; ++q) { egA[q] = *(const LAS f32x4*)(vecl + 8 * q + 4 * h2); egB[q] = *(const LAS f32x4*)(vecl + 32 + 8 * q + 4 * h2); }
                SBAR;
#pragma unroll
                for (int ks = 0; ks < 4; ++ks) { vA = MFMA32(f0[ks], tb[ks], vA); vB = MFMA32(f1[ks], tb[ks], vB); }
#pragma unroll
                for (int q = 0; q < 4; ++q)
#pragma unroll
                    for (int e = 0; e < 4; ++e) { qA[4 * q + e] *= egA[q][e]; qB[4 * q + e] *= egB[q][e]; }
#pragma unroll
                for (int kt = 0; kt < 4; ++kt)
#pragma unroll
                    for (int r = 0; r < 16; ++r) S[kt][r] *= gl;
#pragma unroll
                for (int g = 0; g < 8; ++g) { __builtin_amdgcn_sched_group_barrier(0x8, 1, 0); __builtin_amdgcn_sched_group_barrier(0x2, 6, 0); }
                SBAR;
            }
            bf16x8 vb[4], vsb[4];
            {
                f32x4 ekA[4], ekB[4];
#pragma unroll
                for (int q = 0; q < 4; ++q) { ekA[q] = *(const LAS f32x4*)(vecl + 128 + 8 * q + 4 * h2); ekB[q] = *(const LAS f32x4*)(vecl + 128 + 32 + 8 * q + 4 * h2); }
#pragma unroll
                for (int s = 0; s < 2; ++s) {
                    vb[s] = pack8(vA[8 * s + 0], vA[8 * s + 1], vA[8 * s + 2], vA[8 * s + 3], vA[8 * s + 4], vA[8 * s + 5], vA[8 * s + 6], vA[8 * s + 7]);
                    vb[2 + s] = pack8(vB[8 * s + 0], vB[8 * s + 1], vB[8 * s + 2], vB[8 * s + 3], vB[8 * s + 4], vB[8 * s + 5], vB[8 * s + 6], vB[8 * s + 7]);
                    vsb[s] = pack8(ekA[2 * s][0] * vA[8 * s + 0], ekA[2 * s][1] * vA[8 * s + 1], ekA[2 * s][2] * vA[8 * s + 2], ekA[2 * s][3] * vA[8 * s + 3], ekA[2 * s + 1][0] * vA[8 * s + 4], ekA[2 * s + 1][1] * vA[8 * s + 5], ekA[2 * s + 1][2] * vA[8 * s + 6], ekA[2 * s + 1][3] * vA[8 * s + 7]);
                    vsb[2 + s] = pack8(ekB[2 * s][0] * vB[8 * s + 0], ekB[2 * s][1] * vB[8 * s + 1], ekB[2 * s][2] * vB[8 * s + 2], ekB[2 * s][3] * vB[8 * s + 3], ekB[2 * s + 1][0] * vB[8 * s + 4], ekB[2 * s + 1][1] * vB[8 * s + 5], ekB[2 * s + 1][2] * vB[8 * s + 6], ekB[2 * s + 1][3] * vB[8 * s + 7]);
                }
            }
            SBAR;
            {
                const int g4 = lane >> 4, i16 = lane & 15, q4 = i16 >> 2, pp = i16 & 3, pq = ((pp & 1) << 1) | (pp >> 1);
                const LAS bf16* kb0 = Kp + (4 * h2 + q4) * 136 + 16 * (g4 & 1) + 4 * pq;
                const int nt = dir ? 127 - n : n;
                bf16* ob = og + (size_t)(b * T + 64 * nt) * 512 + h * 128 + vcol;
                s16x4 lo0[4], hi0[4], lo1[4], hi1[4];
#pragma unroll
                for (int ks = 0; ks < 4; ++ks) {
                    lo0[ks] = trread(kb0 + (16 * ks) * 136); hi0[ks] = trread(kb0 + (16 * ks + 8) * 136);
                    lo1[ks] = trread(kb0 + (16 * ks) * 136 + 32); hi1[ks] = trread(kb0 + (16 * ks + 8) * 136 + 32);
                }
                bf16x8 f0[4], f1[4];
#pragma unroll
                for (int ks = 0; ks < 4; ++ks) {
                    f0[ks] = *(const LAS bf16x8*)(QKm + (l31) * 72 + 16 * ks + 8 * h2);
                    f1[ks] = *(const LAS bf16x8*)(QKm + (32 + l31) * 72 + 16 * ks + 8 * h2);
                }
                SBAR;
#pragma unroll
                for (int ks = 0; ks < 4; ++ks) {
                    S[0] = MFMA32(cat8(lo0[ks], hi0[ks]), vsb[ks], S[0]);
                    S[1] = MFMA32(cat8(lo1[ks], hi1[ks]), vsb[ks], S[1]);
                }
#pragma unroll
                for (int ks = 0; ks < 4; ++ks) { qA = MFMA32(f0[ks], vb[ks], qA); qB = MFMA32(f1[ks], vb[ks], qB); }
                SBAR;
#pragma unroll
                for (int ks = 0; ks < 4; ++ks) {
                    lo0[ks] = trread(kb0 + (16 * ks) * 136 + 64); hi0[ks] = trread(kb0 + (16 * ks + 8) * 136 + 64);
                    lo1[ks] = trread(kb0 + (16 * ks) * 136 + 96); hi1[ks] = trread(kb0 + (16 * ks + 8) * 136 + 96);
                }
                SBAR;
#pragma unroll
                for (int ks = 0; ks < 4; ++ks) {
                    S[2] = MFMA32(cat8(lo0[ks], hi0[ks]), vsb[ks], S[2]);
                    S[3] = MFMA32(cat8(lo1[ks], hi1[ks]), vsb[ks], S[3]);
                }
                const int odd = lane & 1;
                bf16* obo = ob + (odd ? (dir ? -512 : 512) - 1 : 0);
#pragma unroll
                for (int mt = 0; mt < 2; ++mt)
#pragma unroll
                    for (int q = 0; q < 4; ++q)
#pragma unroll
                        for (int ep = 0; ep < 2; ++ep) {
                            const float x = mt ? qB[4 * q + 2 * ep] : qA[4 * q + 2 * ep], y = mt ? qB[4 * q + 2 * ep + 1] : qA[4 * q + 2 * ep + 1];
                            const float snd = odd ? x : y;
                            const float rcv = __builtin_bit_cast(float, __builtin_amdgcn_mov_dpp(__builtin_bit_cast(int, snd), 0xB1, 0xF, 0xF, true));
                            const unsigned pk = odd ? pk2(rcv, y) : pk2(x, rcv);
                            const int r = 32 * mt + 8 * q + 4 * h2 + 2 * ep; const int c = dir ? 63 - r : r;
                            if (smode & 4) *(unsigned*)(obo + (ptrdiff_t)c * 512) = pk;
                        }
                SBAR;
            }
            LDS_BARRIER();
        }
    }
}

__device__ __forceinline__ void na_items(const Params& p, int layer, LAS unsigned char* lds, int widx, int wstride) {
    const int lane = otid() & 63, w = otid() >> 6;
    const int fr = lane & 15, fq = lane >> 4;
    const LAS float* rp = (const LAS float*)lds;
    LAS bf16* Vst = (LAS bf16*)(lds + 16384 + w * 5120);
    const bf16* HN = (const bf16*)(p.ws + WS_HN);
    bf16* MIX = (bf16*)((unsigned char*)p.out + OUT_MIX);
    const float* ng = p.na_norm_g + layer * 64;
    for (int it = widx; it < 16384; it += wstride) {
        const int hh = it & 7, j = (it >> 3) & 3, r = (it >> 5) & 127, b = it >> 12;
        int r0 = r - 4; r0 = r0 < 0 ? 0 : (r0 > 120 ? 120 : r0);
        int ss = 16 * j - 8; ss = ss < 0 ? 0 : (ss > 32 ? 32 : ss);
        const int qc = 16 * j + fr;
        int wsn = qc - 8; wsn = wsn < 0 ? 0 : (wsn > 48 ? 48 : wsn);
        const size_t mq = (size_t)b * T + r * 64 + qc;
        bf16x8 Qf[2];
#pragma unroll
        for (int ks = 0; ks < 2; ++ks) Qf[ks] = *(const bf16x8*)(HN + mq * 1536 + hh * 64 + 32 * ks + 8 * fq);
        u32x4 vr[4][4];
#pragma unroll
        for (int i = 0; i < 4; ++i)
#pragma unroll
            for (int m4 = 0; m4 < 4; ++m4) {
                const int idx = lane + 64 * m4, key = idx >> 3, chn = idx & 7;
                const size_t mk = (size_t)b * T + (r0 + i) * 64 + ss + key;
                vr[i][m4] = *(const u32x4*)(HN + mk * 1536 + 1024 + hh * 64 + 8 * chn);
            }
        f32x4 sc[8][2];
#pragma unroll
        for (int i = 0; i < 8; ++i)
#pragma unroll
            for (int t = 0; t < 2; ++t) {
                const size_t mk = (size_t)b * T + (r0 + i) * 64 + ss + 16 * t + fr;
                const bf16x8 k0 = *(const bf16x8*)(HN + mk * 1536 + 512 + hh * 64 + 8 * fq);
                const bf16x8 k1 = *(const bf16x8*)(HN + mk * 1536 + 512 + hh * 64 + 32 + 8 * fq);
                f32x4 a = {0.f, 0.f, 0.f, 0.f};
                a = MFMA16(k0, Qf[0], a); a = MFMA16(k1, Qf[1], a);
                sc[i][t] = a;
            }
        float mx = -INFINITY;
#pragma unroll
        for (int i = 0; i < 8; ++i) {
            const int dr = r0 + i - r + 7;
            const LAS float* rb = rp + (hh * 15 + dr) * 31;
#pragma unroll
            for (int t = 0; t < 2; ++t)
#pragma unroll
                for (int e = 0; e < 4; ++e) {
                    const int kc = ss + 16 * t + 4 * fq + e;
                    int rel = kc - qc + 15; rel = rel < 0 ? 0 : (rel > 30 ? 30 : rel);
                    const bool valid = (kc >= wsn) && (kc < wsn + 16);
                    const float s = valid ? (sc[i][t][e] * 0.125f + rb[rel]) : -INFINITY;
                    sc[i][t][e] = s; mx = fmaxf(mx, s);
                }
        }
        mx = fmaxf(mx, __shfl_xor(mx, 16)); mx = fmaxf(mx, __shfl_xor(mx, 32));
        float sum = 0.f;
#pragma unroll
        for (int i = 0; i < 8; ++i)
#pragma unroll
            for (int t = 0; t < 2; ++t)
#pragma unroll
                for (int e = 0; e < 4; ++e) { const float pe = __expf(sc[i][t][e] - mx); sc[i][t][e] = pe; sum += pe; }
        sum += __shfl_xor(sum, 16); sum += __shfl_xor(sum, 32);
        f32x4 O[4];
#pragma unroll
        for (int dt = 0; dt < 4; ++dt) O[dt] = (f32x4){0.f, 0.f, 0.f, 0.f};
#pragma unroll
        for (int i = 0; i < 8; ++i) {
            WAVE_SYNC();
#pragma unroll
            for (int m4 = 0; m4 < 4; ++m4) { const int idx = lane + 64 * m4, key = idx >> 3, chn = idx & 7; *(LAS u32x4*)(Vst + key * 80 + chn * 8) = vr[i & 3][m4]; }
            if (i + 4 < 8) {
#pragma unroll
                for (int m4 = 0; m4 < 4; ++m4) {
                    const int idx = lane + 64 * m4, key = idx >> 3, chn = idx & 7;
                    const size_t mk = (size_t)b * T + (r0 + i + 4) * 64 + ss + key;
                    vr[i & 3][m4] = *(const u32x4*)(HN + mk * 1536 + 1024 + hh * 64 + 8 * chn);
                }
            }
            WAVE_SYNC();
            const f32x4 p0 = sc[i][0], p1 = sc[i][1];
            const bf16x8 Pf = pack8(p0[0], p0[1], p0[2], p0[3], p1[0], p1[1], p1[2], p1[3]);
            const int q4 = fr >> 2, pp = fr & 3;
#pragma unroll
            for (int dt = 0; dt < 4; ++dt) {
                const s16x4 lo = trread(Vst + (4 * fq + q4) * 80 + 16 * dt + 4 * pp);
                const s16x4 hi = trread(Vst + (16 + 4 * fq + q4) * 80 + 16 * dt + 4 * pp);
                O[dt] = MFMA16(Pf, cat8(lo, hi), O[dt]);
            }
        }
#pragma unroll
        for (int e = 0; e < 4; ++e) {
            const float sm = __shfl(sum, 4 * fq + e);
            const float inv = 1.0f / sm;
            float o0 = O[0][e] * inv, o1 = O[1][e] * inv, o2 = O[2][e] * inv, o3 = O[3][e] * inv;
            float ssq = o0 * o0 + o1 * o1 + o2 * o2 + o3 * o3;
            ssq += __shfl_xor(ssq, 1); ssq += __shfl_xor(ssq, 2); ssq += __shfl_xor(ssq, 4); ssq += __shfl_xor(ssq, 8);
            const float rs = 1.0f / sqrtf(ssq * (1.f / 64.f) + 1e-6f);
            const size_t mo = (size_t)b * T + r * 64 + 16 * j + 4 * fq + e;
            bf16* dst = MIX + mo * 1024 + 512 + hh * 64 + fr;
            dst[0] = f2bf(o0 * rs * ng[fr]); dst[16] = f2bf(o1 * rs * ng[16 + fr]); dst[32] = f2bf(o2 * rs * ng[32 + fr]); dst[48] = f2bf(o3 * rs * ng[48 + fr]);
        }
    }
}
template <int smode = 7> __device__ __forceinline__ void scan_na_phase(const Params& p, int layer, LAS unsigned char* lds, int mode = 3) {
    if (obid() < NSCAN) {
#if !defined(MK_NO_SCAN)
        if (!(mode & 1)) {} else if (obid() & 2) scan_chain<1, smode>(p, layer, lds, obid()); else scan_chain<0, smode>(p, layer, lds, obid());
#endif
    }
    else {
        const float* rpb = p.rpb + (size_t)layer * 8 * 15 * 31;
        for (int i = otid(); i < 8 * 15 * 31; i += 512) ((LAS float*)lds)[i] = rpb[i];
        __syncthreads();
#if !defined(MK_NO_NA)
        if (mode & 2) na_items(p, layer, lds, (obid() - NSCAN) * 8 + (otid() >> 6), ((int)gridDim.x - NSCAN) * 8);
        if ((mode & 2) && layer == 0 && smode == 7) {
            LAS float* scr = (LAS float*)(lds + 65536 + (otid() >> 6) * 8704); const int gw = (obid() - NSCAN) * 8 + (otid() >> 6), ngw = ((int)gridDim.x - NSCAN) * 8;
            convert_weights(p, 0, scr, gw, ngw, otid() & 63, 2);
            convert_weights(p, 1, scr, gw, ngw, otid() & 63, 3);
        }
        if ((mode & 2) && smode == 7) {
            __syncthreads();
            pg8::Gemm gz{(const bf16*)(p.ws + WS_XN), (const bf16*)(p.ws + WS_WIN) + (size_t)layer * NIN * D + (size_t)3328 * D, M, 512, D};
            pg8::StaticOrder Sz; Sz.init(M, 512, (int)gridDim.x - NSCAN, obid() - NSCAN);
            EpiIn Ez{(bf16*)(p.ws + WS_HG), (bf16*)(p.ws + WS_HZ), (bf16*)(p.ws + WS_HN), (float*)(p.ws + WS_AB), 13};
            pg8::gemm_phase<EpiIn, pg8::StaticOrder, true, true>(lds, gz, Sz, Ez);
        }
#endif
    }
}

__device__ __forceinline__ void combine_phase(const Params& p, int layer) {
    const int lane = otid() & 63, gw = obid() * 8 + (otid() >> 6), ngw = gridDim.x * 8;
    const bf16* og = (const bf16*)(p.ws + WS_HG); const bf16* HZ = (const bf16*)(p.ws + WS_HZ); bf16* MIX = (bf16*)((unsigned char*)p.out + OUT_MIX);
    const float* g = p.gdn_norm_g + layer * 128;
    const int col = 8 * lane;
    float gv[8];
#pragma unroll
    for (int k = 0; k < 8; ++k) gv[k] = g[(col & 127) + k];
    for (int m = gw; m < M; m += ngw) {
        const u32x4 a = *(const u32x4*)(og + (size_t)m * 512 + col), bq = *(const u32x4*)(og + (size_t)M * 512 + (size_t)m * 512 + col), z = *(const u32x4*)(HZ + (size_t)m * 512 + col);
        float o[8], zz[8];
#pragma unroll
        for (int k = 0; k < 4; ++k) { o[2 * k] = bflo(a[k]) + bflo(bq[k]); o[2 * k + 1] = bfhi(a[k]) + bfhi(bq[k]); zz[2 * k] = bflo(z[k]); zz[2 * k + 1] = bfhi(z[k]); }
        float ssq = 0.f;
#pragma unroll
        for (int k = 0; k < 8; ++k) ssq += o[k] * o[k];
        ssq += __shfl_xor(ssq, 1); ssq += __shfl_xor(ssq, 2); ssq += __shfl_xor(ssq, 4); ssq += __shfl_xor(ssq, 8);
        const float rs = 1.0f / sqrtf(ssq * (1.f / 128.f) + 1e-6f);
        float y[8];
#pragma unroll
        for (int k = 0; k < 8; ++k) { const float sz = zz[k] * __builtin_amdgcn_rcpf(1.f + __expf(-zz[k])); y[k] = o[k] * rs * gv[k] * sz; }
        u32x4 wv; wv.x = pk2(y[0], y[1]); wv.y = pk2(y[2], y[3]); wv.z = pk2(y[4], y[5]); wv.w = pk2(y[6], y[7]);
        *(u32x4*)(MIX + (size_t)m * 1024 + col) = wv;
    }
}

#define XB_TMO      128
#define XB_XCNT(j)  (256  + 64 * (j))
#define XB_XSUB(j)  (1280 + 64 * (j))
#define XB_XGEN(j)  (2304 + 64 * (j))
#define XB_TOP      3328
#define XB_TOPGEN   3392
#define XCD_BAR_WORDS 3456
#define XB_SPIN_CAP (1u << 18)

__device__ __forceinline__ unsigned xb_ld(unsigned* p)              { return __hip_atomic_load(p, __ATOMIC_RELAXED, __HIP_MEMORY_SCOPE_AGENT); }
__device__ __forceinline__ unsigned xb_add(unsigned* p, unsigned v) { return __hip_atomic_fetch_add(p, v, __ATOMIC_RELAXED, __HIP_MEMORY_SCOPE_AGENT); }
__device__ __forceinline__ unsigned xb_xcc_id() { return (unsigned)__builtin_amdgcn_s_getreg((3 << 11) | 20) & 0xFu; }
#define XB_SPIN(cond, bar) do { unsigned _sp = 0; while (cond) { __builtin_amdgcn_s_sleep(1); \
    if ((++_sp & 255u) == 0u) { if (xb_ld(&(bar)[XB_TMO])) break; if (_sp > XB_SPIN_CAP) { atomicAdd(&(bar)[XB_TMO], 1u); break; } } } } while (0)

struct XcdBarrier {
    unsigned* bar; unsigned x;
    volatile LAS unsigned* st;
};

__device__ __forceinline__ XcdBarrier xcd_barrier_post(unsigned* bar, volatile LAS unsigned* st) {
    XcdBarrier b; b.bar = bar; b.x = xb_xcc_id(); b.st = st;
    if (threadIdx.x == 0) (void)xb_add(&bar[XB_XCNT(b.x)], 1u);
    return b;
}
__device__ __forceinline__ void xcd_barrier_complete(unsigned* bar, unsigned x, unsigned& nloc, unsigned& nx) {
    const unsigned G = gridDim.x * gridDim.y * gridDim.z;
    unsigned sum, cnt, mine, sp = 0u;
    for (;;) {
        sum = 0u; cnt = 0u; mine = 0u;
#pragma unroll
        for (unsigned j = 0; j < 16; ++j) { const unsigned c = xb_ld(&bar[XB_XCNT(j)]); sum += c; cnt += (c > 0u) ? 1u : 0u; mine = (j == x) ? c : mine; }
        if (sum == G) break;
        __builtin_amdgcn_s_sleep(1);
        if ((++sp & 255u) == 0u) { if (xb_ld(&bar[XB_TMO])) break; if (sp > XB_SPIN_CAP) { atomicAdd(&bar[XB_TMO], 1u); break; } }
    }
    nloc = mine > 0u ? mine : 1u; nx = cnt > 0u ? cnt : 1u;
}

__device__ __forceinline__ void xcd_barrier(const XcdBarrier& b) {
    asm volatile("s_waitcnt vmcnt(0)" ::: "memory");
    __syncthreads();
    if (threadIdx.x == 0) {
        unsigned* bar = b.bar;
        __builtin_amdgcn_s_waitcnt(0);
        unsigned nloc = b.st[0], nx = b.st[1];
        if (nloc == 0u) { xcd_barrier_complete(bar, b.x, nloc, nx); b.st[0] = nloc; b.st[1] = nx; }
        const unsigned old = xb_add(&bar[XB_XSUB(b.x)], 1u);
        const unsigned gen = old / nloc;
        if (old + 1u == (gen + 1u) * nloc) {
            __builtin_amdgcn_fence(__ATOMIC_RELEASE, "agent");
            asm volatile("s_waitcnt vmcnt(0)" ::: "memory");
            const unsigned og = xb_add(&bar[XB_TOP], 1u);
            const unsigned tg = og / nx;
            if (og + 1u == (tg + 1u) * nx) xb_add(&bar[XB_TOPGEN], 1u);
            else XB_SPIN(xb_ld(&bar[XB_TOPGEN]) == tg, bar);
            __builtin_amdgcn_fence(__ATOMIC_ACQUIRE, "agent");
            xb_add(&bar[XB_XGEN(b.x)], 1u);
            asm volatile("s_waitcnt vmcnt(0)" ::: "memory");
        } else {
            XB_SPIN(xb_ld(&bar[XB_XGEN(b.x)]) == gen, bar);
            __builtin_amdgcn_fence(__ATOMIC_ACQUIRE, "agent");
            asm volatile("s_waitcnt vmcnt(0)" ::: "memory");
        }
    }
    __syncthreads();
}

typedef const __attribute__((address_space(4))) Params* KParamsPtr;
__device__ __forceinline__ Params load_params() {
#if defined(__HIP_DEVICE_COMPILE__)
    KParamsPtr kp = (KParamsPtr)__builtin_amdgcn_kernarg_segment_ptr(); asm volatile("" : "+s"(kp)); return *kp;
#else
    return Params{};
#endif
}
#if defined(MK_CG_SYNC)
#define GSYNC() grid.sync()
#else
#define GSYNC() xcd_barrier(xbar)
#endif
__global__ void __launch_bounds__(512, 2) mega_fwd(Params p_unused) {
    extern __shared__ __attribute__((aligned(16))) unsigned char lds_raw[];
    cg::grid_group grid = cg::this_grid();
    LAS unsigned char* lds = (LAS unsigned char*)lds_raw;
    volatile LAS unsigned* bst = (volatile LAS unsigned*)(lds + LDS_BYTES - 16);
    if (threadIdx.x == 0) { bst[0] = 0u; bst[1] = 0u; }
    __syncthreads();
    XcdBarrier xbar;
    { const Params p = load_params(); xbar = xcd_barrier_post((unsigned*)p.ws, bst); }
#if defined(MK_DUP_P0)
    { const Params p = load_params(); phase0(p, lds); }
    GSYNC();
#endif
    { const Params p = load_params(); phase0(p, lds); }
    GSYNC();
#if defined(MK_EXTRA_SYNCS)
    for (int i = 0; i < MK_EXTRA_SYNCS; ++i) GSYNC();
#endif
#pragma unroll 1
    for (int l = 0; l < 2; ++l) {
        {
            const Params p = load_params(); const int G = gridDim.x, c = obid();
            ab_phase(p.ws, WS_WIN + ((size_t)l * NIN + 3072) * D * 2);
            pg8::Gemm g{(const bf16*)(p.ws + WS_XN), (const bf16*)(p.ws + WS_WIN) + (size_t)l * NIN * D, M, 3072, D}; pg8::StaticOrder S; S.init(M, 3072, G, c);
            EpiIn E{(bf16*)(p.ws + WS_HG), (bf16*)(p.ws + WS_HZ), (bf16*)(p.ws + WS_HN), (float*)(p.ws + WS_AB), 0};
            pg8::gemm_phase<EpiIn, pg8::StaticOrder, true, true>(lds, g, S, E);
#if defined(MK_DUP_GIN)
            GSYNC();
            pg8::gemm_phase<EpiIn, pg8::StaticOrder, true, true>(lds, g, S, E);
#endif
        }
        GSYNC();
#if !defined(MK_SKIP_MIXER)
#if defined(MK_DUP_PREP_PRE)
        { const Params p = load_params(); prep_phase(p, l, lds, MK_DUP_PREP_PRE); }
        GSYNC();
#endif
#if !defined(MK_SKIP_PREP)
        { const Params p = load_params(); prep_phase(p, l, lds); }
        GSYNC();
#endif
#if defined(MK_DUP_PREP)
        { const Params p = load_params(); prep_phase(p, l, lds, MK_DUP_PREP); }
        GSYNC();
#endif
#if !defined(MK_SKIP_SCAN)
        { const Params p = load_params(); scan_na_phase(p, l, lds); }
        if (l == 0) grid.sync(); else GSYNC();
#endif
#if defined(MK_DUP_SCAN)
        { const Params p = load_params(); scan_na_phase<MK_DUP_SCAN>(p, l, lds, 1); }
        GSYNC();
#endif
#if defined(MK_DUP_NA)
        { const Params p = load_params(); scan_na_phase(p, l, lds, 2); }
        GSYNC();
#endif
        { const Params p = load_params(); combine_phase(p, l); }
        GSYNC();
#endif
        {
            const Params p = load_params(); const int G = gridDim.x, c = obid();
            pg8::Gemm g{(const bf16*)((unsigned char*)p.out + OUT_MIX), (const bf16*)(p.ws + WS_WOUT) + (size_t)l * D * D, M, D, D}; pg8::StaticOrder S; S.init(M, D, G, c);
            EpiRes E{(const bf16*)(p.ws + WS_XN), (bf16*)(p.ws + WS_YB), nullptr};
            pg8::gemm_phase<EpiRes, pg8::StaticOrder, true, true>(lds, g, S, E);
        }
        GSYNC();
        { const Params p = load_params(); ln_phase_b((const bf16*)(p.ws + WS_YB), nullptr, (bf16*)(p.ws + WS_XN), p.ln1_g + l * D, p.ln1_b + l * D); }
        GSYNC();
        {
            const Params p = load_params(); const int G = gridDim.x, c = obid();
            pg8::Gemm g{(const bf16*)(p.ws + WS_XN), (const bf16*)(p.ws + WS_W1) + (size_t)l * D * FF, M, FF, D}; pg8::StaticOrder S; S.init(M, FF, G, c);
            EpiUp E{(bf16*)(p.ws + WS_HB), p.b1 + l * FF};
            pg8::gemm_phase<EpiUp, pg8::StaticOrder, true, true>(lds, g, S, E);
#if defined(MK_DUP_GUP)
            GSYNC();
            pg8::gemm_phase<EpiUp, pg8::StaticOrder, true, true>(lds, g, S, E);
#endif
        }
        GSYNC();
        {
            const Params p = load_params(); const int G = gridDim.x, c = obid();
            pg8::Gemm g{(const bf16*)(p.ws + WS_HB), (const bf16*)(p.ws + WS_W2) + (size_t)l * D * FF, M, D, FF}; pg8::StaticOrder S; S.init(M, D, G, c);
            EpiRes E{(const bf16*)(p.ws + WS_XN), (bf16*)(p.ws + WS_YB), p.b2 + l * D};
            pg8::gemm_phase<EpiRes, pg8::StaticOrder, true, true>(lds, g, S, E);
        }
        GSYNC();
        { const Params p = load_params(); ln_phase_b((const bf16*)(p.ws + WS_YB), (l == 0) ? nullptr : p.out, (l == 0) ? (bf16*)(p.ws + WS_XN) : nullptr, p.ln2_g + l * D, p.ln2_b + l * D); }
        if (l == 0) GSYNC();
    }
#if defined(MK_SANITIZE)
    GSYNC();
    { const Params p = load_params(); for (size_t i = (size_t)obid() * 512 + otid(); i < (size_t)M * D; i += (size_t)gridDim.x * 512) { float v = p.out[i]; if (!(fabsf(v) < 1e30f)) p.out[i] = 100.0f; } }
#endif
}

extern "C" void kernel_launch(void* const* d_in, const int* in_sizes, int n_in, void* d_out, int out_size, void* d_ws, size_t ws_size, hipStream_t stream) {
    static int grid = 0;
    if (grid == 0) {
        if (n_in != 19 || out_size != M * D || ws_size < WS_END) { fprintf(stderr, "kernel_launch: unexpected shapes (n_in %d out %d ws %zu)\n", n_in, out_size, ws_size); grid = -1; return; }
        int dev = 0, cus = 0, per_cu = 0;
        hipGetDevice(&dev);
        hipDeviceGetAttribute(&cus, hipDeviceAttributeMultiprocessorCount, dev);
        hipFuncSetAttribute((const void*)mega_fwd, hipFuncAttributeMaxDynamicSharedMemorySize, LDS_BYTES);
        hipOccupancyMaxActiveBlocksPerMultiprocessor(&per_cu, (const void*)mega_fwd, 512, LDS_BYTES);
        if (per_cu < 1) { fprintf(stderr, "kernel_launch: occupancy query says %d blocks per CU\n", per_cu); per_cu = 1; }
        grid = cus;
        if (cus * 8 < M / 16) { fprintf(stderr, "kernel_launch: needs >= 256 CUs (ab_phase deals one 16-row group per wave)\n"); grid = -1; return; }
        (void)hipGetLastError();
    }
    if (grid < 0) return;
    Params p{};
    const float** pf = (const float**)&p;
    for (int i = 0; i < 19; ++i) pf[i] = (const float*)d_in[i];
    p.out = (float*)d_out; p.ws = (unsigned char*)d_ws;
    hipMemsetAsync(d_ws, 0, 16384, stream);
    void* args[] = {&p};
    hipError_t e = hipLaunchCooperativeKernel((const void*)mega_fwd, dim3(grid), dim3(512), args, LDS_BYTES, stream);
    if (e != hipSuccess) fprintf(stderr, "cooperative launch failed: %s (grid %d)\n", hipGetErrorString(e), grid);
}
```

```cpp
#include <hip/hip_runtime.h>
#include <hip/hip_cooperative_groups.h>
#include <cstdio>
#include <cstdint>
#include <cmath>
namespace pg8 {
#define PG8_LAS __attribute__((address_space(3)))
typedef unsigned short bf16_t;
typedef short bf16x8 __attribute__((ext_vector_type(8)));
typedef float f32x4 __attribute__((ext_vector_type(4)));
typedef unsigned u32x4 __attribute__((ext_vector_type(4)));
constexpr int BM = 256, BK = 64, HALF = 128, HTB = HALF * BK * 2  , STAGE_BYTES = 8 * HTB, NXCD = 8, WGM = 4;

__host__ __device__ __forceinline__ int lds_byte(int r, int c) { const int st = (r >> 4) * 2 + (c >> 5), rr = r & 15, cc = c & 31, ob = rr * 64 + cc * 2; return st * 1024 + (ob ^ (((ob >> 9) & 1) << 5)); }
__host__ __device__ __forceinline__ void stage_rc(int b, int& R, int& C) { const int st = b / 1024, sb = b % 1024, swz = sb ^ (((sb >> 9) & 1) << 5); R = (st >> 1) * 16 + swz / 64; C = (st & 1) * 32 + (swz % 64) / 2; }
__host__ __device__ __forceinline__ int perm32(int rho) { const int n = rho >> 4, i = rho & 15; return 8 * (i >> 2) + 4 * n + (i & 3); }

struct Unit { int pm, pn; };
struct Gemm { const bf16_t* A; const bf16_t* Bt; int M, N, K; };

struct StaticOrder {
    int nM, nN, nwg, G, c;
    __host__ __device__ void init(int M, int N, int G_, int c_) { nM = M / BM; nN = N / BM; nwg = nM * nN; G = G_; c = c_; }
    __host__ __device__ bool next(int i, Unit& u) const {
        const long L = (long)i * G + c; if (L >= nwg) return false;
        int wgid = (int)L; { const int q = nwg / NXCD, r = nwg % NXCD, xcd = wgid % NXCD, off = wgid / NXCD; wgid = (xcd < r ? xcd * (q + 1) : r * (q + 1) + (xcd - r) * q) + off; }
        const int nig = WGM * nN, gid = wgid / nig, fm = gid * WGM, gsz = (nM - fm) < WGM ? (nM - fm) : WGM;
        u.pm = fm + ((wgid % nig) % gsz); u.pn = (wgid % nig) / gsz; return true;
    }
    __device__ __forceinline__ void a_ready(const Unit&) const {}
    __device__ __forceinline__ void done(const Unit&) const {}
};

__device__ __forceinline__ unsigned cvt_pk_bf16(float lo, float hi) { unsigned r; asm volatile("v_cvt_pk_bf16_f32 %0, %1, %2" : "=v"(r) : "v"(lo), "v"(hi)); return r; }
typedef float f32x2 __attribute__((ext_vector_type(2)));
template <class Epi, class Sched, bool ALIGN_EPI = false, bool SP2 = false>
__device__ __forceinline__ void gemm_phase(PG8_LAS unsigned char* lds, const Gemm g, const Sched& S, const Epi& E) {
    int tid_ = threadIdx.x; asm volatile("" : "+v"(tid_)); const int tid = tid_, wid = __builtin_amdgcn_readfirstlane(tid >> 6), lane = tid & 63, wr = wid >> 2, wc = wid & 3, fr = lane & 15, fq = lane >> 4;
    const int K = g.K, nt = K / BK;
    unsigned voffA[2], voffB[2];
#pragma unroll
    for (int i = 0; i < 2; ++i) { int R, C; stage_rc(tid * 16 + i * 8192, R, C); const int Rb = Epi::PERM ? ((R & ~31) + perm32(R & 31)) : R;
        voffA[i] = (unsigned)(R * K + C) * 2u; voffB[i] = (unsigned)(Rb * K + C) * 2u; }
    const size_t kstep = (size_t)(BK * 2);
    const size_t hstep = (size_t)HALF * K * 2;
    const size_t tstep = 2 * hstep;
    const unsigned ldsw = (unsigned)wid * 1024u;
    const int aoff = lds_byte(wr * 64 + fr, fq * 8), boff = lds_byte(wc * 32 + fr, fq * 8);
#define PG8_SA(b, h) (((b) * 2 + (h)) * HTB)
#define PG8_SB(b, h) ((4 + (b) * 2 + (h)) * HTB)
#define PG8_STAGE(bufoff, gbase, voff) do { _Pragma("unroll") for (int _i = 0; _i < 2; ++_i) \
        __builtin_amdgcn_global_load_lds((const unsigned*)((const char*)(gbase) + (voff)[_i]), (PG8_LAS unsigned*)(lds + (bufoff) + ldsw + _i * 8192), 16, 0, 0); } while (0)
#define PG8_LDA(dst, b, h) do { _Pragma("unroll") for (int m = 0; m < 4; ++m) _Pragma("unroll") for (int k = 0; k < 2; ++k) dst[m][k] = *(const PG8_LAS bf16x8*)(lds + PG8_SA(b, h) + aoff + m * 2048 + k * 1024); } while (0)
#define PG8_LDB(dst, b, h) do { _Pragma("unroll") for (int n = 0; n < 2; ++n) _Pragma("unroll") for (int k = 0; k < 2; ++k) dst[n][k] = *(const PG8_LAS bf16x8*)(lds + PG8_SB(b, h) + boff + n * 2048 + k * 1024); } while (0)
#define PG8_MMA(ai, bj, At, Bt) do { __builtin_amdgcn_s_setprio(1); _Pragma("unroll") for (int m = 0; m < 4; ++m) _Pragma("unroll") for (int n = 0; n < 2; ++n) _Pragma("unroll") for (int k = 0; k < 2; ++k) \
        acc[ai][bj][m][n] = __builtin_amdgcn_mfma_f32_16x16x32_bf16(Bt[n][k], At[m][k], acc[ai][bj][m][n], 0, 0, 0); __builtin_amdgcn_s_setprio(0); } while (0)
#define PG8_WAIT_V(n) asm volatile("s_waitcnt vmcnt(" #n ")" ::: "memory")
#define PG8_WAIT_L(n) asm volatile("s_waitcnt lgkmcnt(" #n ")" ::: "memory")
#define PG8_BAR __builtin_amdgcn_s_barrier()
#define PG8_SCHED __builtin_amdgcn_sched_barrier(0)
    Unit cur, nxt; int ui = 0;
    if (!S.next(0, cur)) return;
    f32x4 acc[2][2][4][2];
#pragma unroll
    for (int a = 0; a < 2; ++a)
#pragma unroll
        for (int b = 0; b < 2; ++b)
#pragma unroll
            for (int m = 0; m < 4; ++m)
#pragma unroll
                for (int n = 0; n < 2; ++n) acc[a][b][m][n] = (f32x4){0.f, 0.f, 0.f, 0.f};
    bf16x8 At[4][2], B0[2][2], B1[2][2];
    const char* cA = (const char*)g.A + (size_t)cur.pm * tstep; const char* cB = (const char*)g.Bt + (size_t)cur.pn * tstep;
    S.a_ready(cur);
    if constexpr (SP2) {
        PG8_STAGE(PG8_SB(0, 0), cB, voffB); PG8_STAGE(PG8_SB(0, 1), cB + hstep, voffB); PG8_STAGE(PG8_SA(0, 0), cA, voffA); PG8_STAGE(PG8_SA(0, 1), cA + hstep, voffA);
        if (wr == 1) PG8_BAR;
        PG8_WAIT_V(2); PG8_BAR;
        PG8_STAGE(PG8_SB(1, 0), cB + kstep, voffB); PG8_STAGE(PG8_SA(1, 0), cA + kstep, voffA); PG8_STAGE(PG8_SB(1, 1), cB + hstep + kstep, voffB);
        PG8_WAIT_V(6); PG8_BAR;
    } else {
        PG8_STAGE(PG8_SB(0, 0), cB, voffB); PG8_STAGE(PG8_SA(0, 0), cA, voffA); PG8_STAGE(PG8_SB(0, 1), cB + hstep, voffB); PG8_STAGE(PG8_SA(0, 1), cA + hstep, voffA);
        if (wr == 1) PG8_BAR;
        PG8_WAIT_V(4); PG8_BAR;
        PG8_STAGE(PG8_SB(1, 0), cB + kstep, voffB); PG8_STAGE(PG8_SA(1, 0), cA + kstep, voffA); PG8_STAGE(PG8_SB(1, 1), cB + hstep + kstep, voffB);
        PG8_WAIT_V(6); PG8_BAR;
    }
    for (;;) {
        const bool has_next = S.next(ui + 1, nxt);
        const char* nA = has_next ? (const char*)g.A + (size_t)nxt.pm * tstep : cA; const char* nB = has_next ? (const char*)g.Bt + (size_t)nxt.pn * tstep : cB;
        for (int t = 0; t < nt; t += 2) {
            const bool last = (t == nt - 2);
            const char* a1 = cA + (size_t)(t + 1) * kstep;
            const char* a2 = last ? nA : cA + (size_t)(t + 2) * kstep; const char* b2 = last ? nB : cB + (size_t)(t + 2) * kstep;
            const char* a3 = a2 + kstep; const char* b3 = b2 + kstep;
            if (last && has_next) S.a_ready(nxt);
            if constexpr (SP2) {
            PG8_LDB(B0, 0, 0); PG8_LDB(B1, 0, 1); PG8_SCHED; PG8_LDA(At, 0, 0); PG8_STAGE(PG8_SA(1, 1), a1 + hstep, voffA);
            PG8_WAIT_V(8); PG8_WAIT_L(0); PG8_BAR; PG8_MMA(0, 0, At, B0); PG8_MMA(0, 1, At, B1); PG8_BAR; PG8_SCHED;
            PG8_LDA(At, 0, 1); PG8_STAGE(PG8_SB(0, 0), b2, voffB); PG8_STAGE(PG8_SB(0, 1), b2 + hstep, voffB); PG8_STAGE(PG8_SA(0, 0), a2, voffA);
            PG8_WAIT_V(8); PG8_WAIT_L(0); PG8_BAR; PG8_MMA(1, 0, At, B0); PG8_MMA(1, 1, At, B1); PG8_BAR; PG8_SCHED;
            PG8_LDB(B0, 1, 0); PG8_LDB(B1, 1, 1); PG8_SCHED; PG8_LDA(At, 1, 0); PG8_STAGE(PG8_SA(0, 1), a2 + hstep, voffA);
            PG8_WAIT_V(8); PG8_WAIT_L(0); PG8_BAR; PG8_MMA(0, 0, At, B0); PG8_MMA(0, 1, At, B1); PG8_BAR; PG8_SCHED;
            PG8_LDA(At, 1, 1); PG8_STAGE(PG8_SB(1, 0), b3, voffB); PG8_STAGE(PG8_SB(1, 1), b3 + hstep, voffB); PG8_STAGE(PG8_SA(1, 0), a3, voffA);
            PG8_WAIT_V(8); PG8_WAIT_L(0); PG8_BAR; PG8_MMA(1, 0, At, B0); PG8_MMA(1, 1, At, B1); PG8_BAR; PG8_SCHED;
            } else {
            PG8_LDB(B0, 0, 0); PG8_SCHED; PG8_LDA(At, 0, 0); PG8_STAGE(PG8_SA(1, 1), a1 + hstep, voffA);
            PG8_WAIT_L(8); PG8_BAR; PG8_WAIT_L(0); PG8_MMA(0, 0, At, B0); PG8_BAR; PG8_SCHED;
            PG8_LDB(B1, 0, 1); PG8_STAGE(PG8_SB(0, 0), b2, voffB);
            PG8_BAR; PG8_WAIT_L(0); PG8_MMA(0, 1, At, B1); PG8_BAR;
            PG8_LDA(At, 0, 1); PG8_STAGE(PG8_SA(0, 0), a2, voffA);
            PG8_BAR; PG8_WAIT_L(0); PG8_MMA(1, 0, At, B0); PG8_BAR; PG8_SCHED;
            PG8_STAGE(PG8_SB(0, 1), b2 + hstep, voffB);
            PG8_WAIT_V(6); PG8_BAR; PG8_MMA(1, 1, At, B1); PG8_BAR;
            PG8_LDB(B0, 1, 0); PG8_SCHED; PG8_LDA(At, 1, 0); PG8_STAGE(PG8_SA(0, 1), a2 + hstep, voffA);
            PG8_WAIT_L(8); PG8_BAR; PG8_WAIT_L(0); PG8_MMA(0, 0, At, B0); PG8_BAR; PG8_SCHED;
            PG8_LDB(B1, 1, 1); PG8_STAGE(PG8_SB(1, 0), b3, voffB);
            PG8_BAR; PG8_WAIT_L(0); PG8_MMA(0, 1, At, B1); PG8_BAR;
            PG8_LDA(At, 1, 1); PG8_STAGE(PG8_SA(1, 0), a3, voffA);
            PG8_BAR; PG8_WAIT_L(0); PG8_MMA(1, 0, At, B0); PG8_BAR; PG8_SCHED;
            PG8_STAGE(PG8_SB(1, 1), b3 + hstep, voffB);
            PG8_WAIT_V(6); PG8_BAR; PG8_MMA(1, 1, At, B1); PG8_BAR;
            }
        }
        if constexpr (ALIGN_EPI) { if (wr == 0) PG8_BAR; }
        if constexpr (!Epi::AFTER_DRAIN) { E(acc, cur, wr, wc, fr, fq); S.done(cur); }
        if (!has_next) break;
#pragma unroll
        for (int a = 0; a < 2; ++a)
#pragma unroll
            for (int b = 0; b < 2; ++b)
#pragma unroll
                for (int m = 0; m < 4; ++m)
#pragma unroll
                    for (int n = 0; n < 2; ++n) acc[a][b][m][n] = (f32x4){0.f, 0.f, 0.f, 0.f};
        cur = nxt; cA = nA; cB = nB; ++ui;
        if constexpr (ALIGN_EPI) { if (wr == 1) PG8_BAR; }
    }
    PG8_WAIT_V(0);
    if constexpr (!ALIGN_EPI) { if (wr == 0) PG8_BAR; }
    PG8_BAR;
    if constexpr (Epi::AFTER_DRAIN) { E.fused(acc, cur, wr, wc, fr, fq, lds, wid, lane); S.done(cur); }
#undef PG8_SA
#undef PG8_SB
#undef PG8_STAGE
#undef PG8_LDA
#undef PG8_LDB
#undef PG8_MMA
#undef PG8_WAIT_V
#undef PG8_WAIT_L
#undef PG8_BAR
#undef PG8_SCHED
}
}

namespace cg = cooperative_groups;
typedef unsigned short bf16;
typedef short bf16x8 __attribute__((ext_vector_type(8)));
typedef short s16x4 __attribute__((ext_vector_type(4)));
typedef float f32x4 __attribute__((ext_vector_type(4)));
typedef float f32x16 __attribute__((ext_vector_type(16)));
typedef unsigned u32x4 __attribute__((ext_vector_type(4)));
typedef unsigned u32x2 __attribute__((ext_vector_type(2)));
#define LAS __attribute__((address_space(3)))

constexpr int NB = 4, T = 8192, M = NB * T, D = 1024, FF = 4096;
constexpr int NIN = 3840;
constexpr float ALPHA = 1.41421356237309515f;
constexpr int LDS_BYTES = 147456;
constexpr int NSCAN = 64;

constexpr size_t MiB = 1u << 20;
constexpr size_t WS_WIN = 1 * MiB, WS_WOUT = 16 * MiB, WS_W1 = 20 * MiB, WS_W2 = 36 * MiB;
constexpr size_t WS_AB = 52 * MiB, WS_XN = 54 * MiB, WS_HZ = 118 * MiB, WS_HN = 150 * MiB, WS_HG = 246 * MiB;
constexpr size_t WS_RQ = 342 * MiB, WS_RK = 374 * MiB, WS_RV = 406 * MiB;
constexpr size_t WS_RTI = 438 * MiB, WS_RQK = 470 * MiB, WS_VEC = 502 * MiB;
constexpr size_t WS_HB = 150 * MiB;
constexpr size_t WS_YB = 406 * MiB;
constexpr size_t OUT_MIX = 64 * MiB;
constexpr size_t WS_END = 506 * MiB;

struct Params {
    const float *x, *ln_in_g, *ln_in_b, *w_in, *conv_w, *a_log, *dt_bias, *gdn_norm_g, *rpb, *na_norm_g, *w_out, *ln1_g, *ln1_b, *w1, *b1, *w2, *b2, *ln2_g, *ln2_b;
    float* out; unsigned char* ws;
};

typedef __bf16 bf16v2_t __attribute__((ext_vector_type(2)));
typedef float f32v2_t __attribute__((ext_vector_type(2)));
__device__ __forceinline__ unsigned pk2(float lo, float hi) { f32v2_t f = {lo, hi}; bf16v2_t b = __builtin_convertvector(f, bf16v2_t); return __builtin_bit_cast(unsigned, b); }
__device__ __forceinline__ unsigned short f2bf(float f) { return (unsigned short)(pk2(f, 0.f) & 0xffffu); }
__device__ __forceinline__ float bflo(unsigned u) { return __uint_as_float(u << 16); }
__device__ __forceinline__ float bfhi(unsigned u) { return __uint_as_float(u & 0xffff0000u); }
__device__ __forceinline__ int ppos(int o) { return (o & ~12) | ((o & 4) << 1) | ((o & 8) >> 1); }
__device__ __forceinline__ float wave_sum(float v) {
#pragma unroll
    for (int o = 1; o < 64; o <<= 1) v += __shfl_xor(v, o);
    return v;
}
__device__ __forceinline__ bf16x8 pack8(float a0, float a1, float a2, float a3, float a4, float a5, float a6, float a7) {
    u32x4 u; u.x = pk2(a0, a1); u.y = pk2(a2, a3); u.z = pk2(a4, a5); u.w = pk2(a6, a7);
    return __builtin_bit_cast(bf16x8, u);
}
#define MFMA32(a, b, c) __builtin_amdgcn_mfma_f32_32x32x16_bf16((a), (b), (c), 0, 0, 0)
#define MFMA16(a, b, c) __builtin_amdgcn_mfma_f32_16x16x32_bf16((a), (b), (c), 0, 0, 0)
typedef short v4i16_t __attribute__((ext_vector_type(4)));
__device__ __forceinline__ s16x4 trread(const LAS bf16* p) { return __builtin_bit_cast(s16x4, __builtin_amdgcn_ds_read_tr16_b64_v4i16((LAS v4i16_t*)p)); }
__device__ __forceinline__ bf16x8 cat8(s16x4 lo, s16x4 hi) { bf16x8 r; r[0] = lo[0]; r[1] = lo[1]; r[2] = lo[2]; r[3] = lo[3]; r[4] = hi[0]; r[5] = hi[1]; r[6] = hi[2]; r[7] = hi[3]; return r; }
#define LDS_BARRIER() do { asm volatile("s_waitcnt lgkmcnt(0)" ::: "memory"); __builtin_amdgcn_s_barrier(); asm volatile("" ::: "memory"); } while (0)
#define SBAR __builtin_amdgcn_sched_barrier(0)
#define WAVE_SYNC() do { __builtin_amdgcn_fence(__ATOMIC_RELEASE, "wavefront"); __builtin_amdgcn_wave_barrier(); __builtin_amdgcn_fence(__ATOMIC_ACQUIRE, "wavefront"); } while (0)

__device__ __forceinline__ int otid() { int t = threadIdx.x; asm volatile("" : "+v"(t)); return t; }
__device__ __forceinline__ int obid() { int t = blockIdx.x; asm volatile("" : "+s"(t)); return t; }

struct EpiIn {
    static constexpr bool PERM = true, AFTER_DRAIN = false;
    bf16 *HG, *HZ, *HN; float* AB; int pn_off;
    __device__ __forceinline__ void operator()(const f32x4 (&acc)[2][2][4][2], const pg8::Unit& u, int wr, int wc, int fr, int fq) const {
        const int row0 = u.pm * 256 + wr * 64 + fr;
        const int pn = u.pn + pn_off;
        if (pn != 12) {
            bf16* base; int ldc, colt;
            if (pn < 6) { base = HG; ldc = 1536; colt = pn * 256; }
            else if (pn < 12) { base = HN; ldc = 1536; colt = (pn - 6) * 256; }
            else { base = HZ; ldc = 512; colt = (pn - 13) * 256; }
            const int col0 = colt + wc * 32 + 8 * fq;
#pragma unroll
            for (int ai = 0; ai < 2; ++ai)
#pragma unroll
                for (int m = 0; m < 4; ++m) {
                    bf16* rowp = base + (size_t)(row0 + ai * 128 + m * 16) * ldc + col0;
#pragma unroll
                    for (int bj = 0; bj < 2; ++bj) {
                        const f32x4 v0 = acc[ai][bj][m][0], v1 = acc[ai][bj][m][1];
                        u32x4 w; w.x = pk2(v0[0], v0[1]); w.y = pk2(v0[2], v0[3]); w.z = pk2(v1[0], v1[1]); w.w = pk2(v1[2], v1[3]);
                        *(u32x4*)(rowp + bj * 128) = w;
                    }
                }
        } else {
            if (wc == 0 && fq < 2) {
#pragma unroll
                for (int ai = 0; ai < 2; ++ai)
#pragma unroll
                    for (int m = 0; m < 4; ++m) {
                        float* rp = AB + (size_t)(row0 + ai * 128 + m * 16) * 16 + 8 * fq;
                        *(f32x4*)(rp) = acc[ai][0][m][0];
                        *(f32x4*)(rp + 4) = acc[ai][0][m][1];
                    }
            }
        }
    }
};
struct EpiUp {
    static constexpr bool PERM = true, AFTER_DRAIN = false;
    bf16* O; const float* bias;
    __device__ __forceinline__ void operator()(const f32x4 (&acc)[2][2][4][2], const pg8::Unit& u, int wr, int wc, int fr, int fq) const {
        const int row0 = u.pm * 256 + wr * 64 + fr;
        const int col0 = u.pn * 256 + wc * 32 + 8 * fq;
        f32x4 bv[2][2];
#pragma unroll
        for (int bj = 0; bj < 2; ++bj)
#pragma unroll
            for (int n = 0; n < 2; ++n) bv[bj][n] = *(const f32x4*)(bias + col0 + bj * 128 + 4 * n);
#pragma unroll
        for (int ai = 0; ai < 2; ++ai)
#pragma unroll
            for (int m = 0; m < 4; ++m) {
                bf16* rowp = O + (size_t)(row0 + ai * 128 + m * 16) * FF + col0;
#pragma unroll
                for (int bj = 0; bj < 2; ++bj) {
                    f32x4 v0 = acc[ai][bj][m][0] + bv[bj][0], v1 = acc[ai][bj][m][1] + bv[bj][1];
#pragma unroll
                    for (int e = 0; e < 4; ++e) { const float a = fmaxf(v0[e], 0.f), b = fmaxf(v1[e], 0.f); v0[e] = a * a; v1[e] = b * b; }
                    u32x4 w; w.x = pk2(v0[0], v0[1]); w.y = pk2(v0[2], v0[3]); w.z = pk2(v1[0], v1[1]); w.w = pk2(v1[2], v1[3]);
                    *(u32x4*)(rowp + bj * 128) = w;
                }
            }
    }
};
struct EpiRes {
    static constexpr bool PERM = true, AFTER_DRAIN = false;
    const bf16* XR; bf16* Y; const float* bias;
    __device__ __forceinline__ void operator()(const f32x4 (&acc)[2][2][4][2], const pg8::Unit& u, int wr, int wc, int fr, int fq) const {
        const int row0 = u.pm * 256 + wr * 64 + fr;
        const int col0 = u.pn * 256 + wc * 32 + 8 * fq;
#pragma unroll
        for (int ai = 0; ai < 2; ++ai)
#pragma unroll
            for (int m = 0; m < 4; ++m) {
                const size_t off = (size_t)(row0 + ai * 128 + m * 16) * D + col0;
#pragma unroll
                for (int bj = 0; bj < 2; ++bj) {
                    const u32x4 xr = *(const u32x4*)(XR + off + bj * 128);
                    f32x4 b0 = {0.f, 0.f, 0.f, 0.f}, b1 = {0.f, 0.f, 0.f, 0.f};
                    if (bias) { b0 = *(const f32x4*)(bias + col0 + bj * 128); b1 = *(const f32x4*)(bias + col0 + bj * 128 + 4); }
                    const f32x4 v0 = acc[ai][bj][m][0] + b0, v1 = acc[ai][bj][m][1] + b1;
                    u32x4 w;
                    w.x = pk2(ALPHA * bflo(xr.x) + v0[0], ALPHA * bfhi(xr.x) + v0[1]); w.y = pk2(ALPHA * bflo(xr.y) + v0[2], ALPHA * bfhi(xr.y) + v0[3]);
                    w.z = pk2(ALPHA * bflo(xr.z) + v1[0], ALPHA * bfhi(xr.z) + v1[1]); w.w = pk2(ALPHA * bflo(xr.w) + v1[2], ALPHA * bfhi(xr.w) + v1[3]);
                    *(u32x4*)(Y + off + bj * 128) = w;
                }
            }
    }
};

__device__ __forceinline__ void tr_item(const float* W, int ld, int K, int src_col0, int nvalid, bf16* WT, int dst_row0, LAS float* scr, int kb, int nb, int lane) {
    const int k0 = 64 * kb, n0 = 32 * nb;
    const int nq = (lane & 7) * 4, n = n0 + nq;
#pragma unroll
    for (int i = 0; i < 8; ++i) {
        const int kk = 8 * i + (lane >> 3);
        f32x4 v = {0.f, 0.f, 0.f, 0.f};
        if (n < nvalid) v = *(const f32x4*)(W + (size_t)(k0 + kk) * ld + src_col0 + n);
        scr[kk * 33 + nq + 0] = v[0]; scr[kk * 33 + nq + 1] = v[1]; scr[kk * 33 + nq + 2] = v[2]; scr[kk * 33 + nq + 3] = v[3];
    }
    WAVE_SYNC();
    const int c = lane & 7;
#pragma unroll
    for (int j = 0; j < 4; ++j) {
        const int nn = (lane >> 3) + 8 * j; const LAS float* s = scr + (8 * c) * 33 + nn;
        u32x4 o; o.x = pk2(s[0 * 33], s[1 * 33]); o.y = pk2(s[2 * 33], s[3 * 33]); o.z = pk2(s[4 * 33], s[5 * 33]); o.w = pk2(s[6 * 33], s[7 * 33]);
        *(u32x4*)(WT + (size_t)(dst_row0 + n0 + nn) * K + k0 + 8 * c) = o;
    }
    WAVE_SYNC();
}
__device__ __forceinline__ void ln_row(const float* src, float* dstf, bf16* dstb, const float* g, const float* b, int lane) {
    f32x4 v[4]; float s = 0.f;
#pragma unroll
    for (int j = 0; j < 4; ++j) { v[j] = *(const f32x4*)(src + 4 * lane + 256 * j); s += (v[j][0] + v[j][1]) + (v[j][2] + v[j][3]); }
    const float mean = wave_sum(s) * (1.f / D); float s2 = 0.f;
#pragma unroll
    for (int j = 0; j < 4; ++j) { v[j] = v[j] - mean; s2 += (v[j][0] * v[j][0] + v[j][1] * v[j][1]) + (v[j][2] * v[j][2] + v[j][3] * v[j][3]); }
    const float rstd = 1.0f / sqrtf(wave_sum(s2) * (1.f / D) + 1e-5f);
#pragma unroll
    for (int j = 0; j < 4; ++j) {
        const f32x4 gv = *(const f32x4*)(g + 4 * lane + 256 * j), bv = *(const f32x4*)(b + 4 * lane + 256 * j);
        const f32x4 y = v[j] * rstd * gv + bv;
        if (dstf) *(f32x4*)(dstf + 4 * lane + 256 * j) = y;
        if (dstb) { u32x2 w; w.x = pk2(y[0], y[1]); w.y = pk2(y[2], y[3]); *(u32x2*)(dstb + 4 * lane + 256 * j) = w; }
    }
}
__device__ __forceinline__ void ln_row_b(const bf16* src, float* dstf, bf16* dstb, const float* g, const float* b, int lane) {
    float v[16]; float s = 0.f;
#pragma unroll
    for (int j = 0; j < 2; ++j) {
        const u32x4 u = *(const u32x4*)(src + 8 * lane + 512 * j);
#pragma unroll
        for (int k = 0; k < 4; ++k) { v[8 * j + 2 * k] = bflo(u[k]); v[8 * j + 2 * k + 1] = bfhi(u[k]); }
    }
#pragma unroll
    for (int k = 0; k < 16; ++k) s += v[k];
    const float mean = wave_sum(s) * (1.f / D); float s2 = 0.f;
#pragma unroll
    for (int k = 0; k < 16; ++k) { v[k] -= mean; s2 += v[k] * v[k]; }
    const float rstd = 1.0f / sqrtf(wave_sum(s2) * (1.f / D) + 1e-5f);
#pragma unroll
    for (int j = 0; j < 2; ++j) {
        const f32x4 g0 = *(const f32x4*)(g + 8 * lane + 512 * j), g1 = *(const f32x4*)(g + 8 * lane + 512 * j + 4);
        const f32x4 b0 = *(const f32x4*)(b + 8 * lane + 512 * j), b1 = *(const f32x4*)(b + 8 * lane + 512 * j + 4);
        f32x4 y0, y1;
#pragma unroll
        for (int k = 0; k < 4; ++k) { y0[k] = v[8 * j + k] * rstd * g0[k] + b0[k]; y1[k] = v[8 * j + 4 + k] * rstd * g1[k] + b1[k]; }
        if (dstf) { *(f32x4*)(dstf + 8 * lane + 512 * j) = y0; *(f32x4*)(dstf + 8 * lane + 512 * j + 4) = y1; }
        if (dstb) { u32x4 w; w.x = pk2(y0[0], y0[1]); w.y = pk2(y0[2], y0[3]); w.z = pk2(y1[0], y1[1]); w.w = pk2(y1[2], y1[3]); *(u32x4*)(dstb + 8 * lane + 512 * j) = w; }
    }
}
__device__ __forceinline__ void ln_rows_b2(const bf16* s0, const bf16* s1, float* f0, float* f1, bf16* d0, bf16* d1, const float* g, const float* b, int lane) {
    float v[2][16]; float s[2] = {0.f, 0.f};
#pragma unroll
    for (int r = 0; r < 2; ++r)
#pragma unroll
        for (int j = 0; j < 2; ++j) {
            const u32x4 u = *(const u32x4*)((r ? s1 : s0) + 8 * lane + 512 * j);
#pragma unroll
            for (int k = 0; k < 4; ++k) { v[r][8 * j + 2 * k] = bflo(u[k]); v[r][8 * j + 2 * k + 1] = bfhi(u[k]); }
        }
#pragma unroll
    for (int k = 0; k < 16; ++k) { s[0] += v[0][k]; s[1] += v[1][k]; }
#pragma unroll
    for (int o = 1; o < 64; o <<= 1) { s[0] += __shfl_xor(s[0], o); s[1] += __shfl_xor(s[1], o); }
    const float mean0 = s[0] * (1.f / D), mean1 = s[1] * (1.f / D); float q0 = 0.f, q1 = 0.f;
#pragma unroll
    for (int k = 0; k < 16; ++k) { v[0][k] -= mean0; q0 += v[0][k] * v[0][k]; v[1][k] -= mean1; q1 += v[1][k] * v[1][k]; }
#pragma unroll
    for (int o = 1; o < 64; o <<= 1) { q0 += __shfl_xor(q0, o); q1 += __shfl_xor(q1, o); }
    const float rstd0 = 1.0f / sqrtf(q0 * (1.f / D) + 1e-5f), rstd1 = 1.0f / sqrtf(q1 * (1.f / D) + 1e-5f);
#pragma unroll
    for (int j = 0; j < 2; ++j) {
        const f32x4 g0 = *(const f32x4*)(g + 8 * lane + 512 * j), g1 = *(const f32x4*)(g + 8 * lane + 512 * j + 4);
        const f32x4 b0 = *(const f32x4*)(b + 8 * lane + 512 * j), b1 = *(const f32x4*)(b + 8 * lane + 512 * j + 4);
#pragma unroll
        for (int r = 0; r < 2; ++r) {
            const float rstd = r ? rstd1 : rstd0;
            f32x4 y0, y1;
#pragma unroll
            for (int k = 0; k < 4; ++k) { y0[k] = v[r][8 * j + k] * rstd * g0[k] + b0[k]; y1[k] = v[r][8 * j + 4 + k] * rstd * g1[k] + b1[k]; }
            float* df = r ? f1 : f0; bf16* db = r ? d1 : d0;
            if (df) { *(f32x4*)(df + 8 * lane + 512 * j) = y0; *(f32x4*)(df + 8 * lane + 512 * j + 4) = y1; }
            if (db) { u32x4 w; w.x = pk2(y0[0], y0[1]); w.y = pk2(y0[2], y0[3]); w.z = pk2(y1[0], y1[1]); w.w = pk2(y1[2], y1[3]); *(u32x4*)(db + 8 * lane + 512 * j) = w; }
        }
    }
}
__device__ __forceinline__ void ln_phase_b(const bf16* src, float* dstf, bf16* dstb, const float* g, const float* b) {
    const int lane = otid() & 63, gw = obid() * 8 + (otid() >> 6), ngw = gridDim.x * 8;
    int m = gw;
    for (; m + ngw < M; m += 2 * ngw) {
        const size_t o0 = (size_t)m * D, o1 = (size_t)(m + ngw) * D;
        ln_rows_b2(src + o0, src + o1, dstf ? dstf + o0 : nullptr, dstf ? dstf + o1 : nullptr, dstb ? dstb + o0 : nullptr, dstb ? dstb + o1 : nullptr, g, b, lane);
    }
    for (; m < M; m += ngw) ln_row_b(src + (size_t)m * D, dstf ? dstf + (size_t)m * D : nullptr, dstb ? dstb + (size_t)m * D : nullptr, g, b, lane);
}
__device__ __forceinline__ void ln_phase(const float* src, float* dstf, bf16* dstb, const float* g, const float* b) {
    const int lane = otid() & 63, gw = obid() * 8 + (otid() >> 6), ngw = gridDim.x * 8;
    for (int m = gw; m < M; m += ngw) ln_row(src + (size_t)m * D, dstf ? dstf + (size_t)m * D : nullptr, dstb ? dstb + (size_t)m * D : nullptr, g, b, lane);
}
__device__ __forceinline__ void convert_weights(const Params& p, int l, LAS float* scr, int gw, int ngw, int lane, int part) {
    constexpr int I_A = 48 * 16, I_B = 48 * 16, I_C = 8 * 16, I_Z = 16 * 16, I_O = 32 * 16, I_1 = 128 * 16, I_2 = 32 * 64;
    constexpr int PER_L = I_A + I_B + I_C + I_Z + I_O + I_1 + I_2;
    const float* win = p.w_in + (size_t)l * D * 3600;
    bf16* winT = (bf16*)(p.ws + WS_WIN) + (size_t)l * NIN * D;
    const int lo = (part & 1) ? 0 : (I_A + I_B + I_C + I_Z), hi = (part & 2) ? PER_L : (I_A + I_B + I_C + I_Z);
    for (int it = lo + gw; it < hi; it += ngw) {
        int r = it;
        if (r < I_A) { tr_item(win, 3600, D, 0, 1536, winT, 0, scr, r / 48, r % 48, lane); continue; } r -= I_A;
        if (r < I_B) { tr_item(win, 3600, D, 2064, 1536, winT, 1536, scr, r / 48, r % 48, lane); continue; } r -= I_B;
        if (r < I_C) { tr_item(win, 3600, D, 2048, 16, winT, 3072, scr, r / 8, r % 8, lane); continue; } r -= I_C;
        if (r < I_Z) { tr_item(win, 3600, D, 1536, 512, winT, 3328, scr, r / 16, r % 16, lane); continue; } r -= I_Z;
        if (r < I_O) { tr_item(p.w_out + (size_t)l * D * D, D, D, 0, D, (bf16*)(p.ws + WS_WOUT) + (size_t)l * D * D, 0, scr, r / 32, r % 32, lane); continue; } r -= I_O;
        if (r < I_1) { tr_item(p.w1 + (size_t)l * D * FF, FF, D, 0, FF, (bf16*)(p.ws + WS_W1) + (size_t)l * D * FF, 0, scr, r / 128, r % 128, lane); continue; } r -= I_1;
        tr_item(p.w2 + (size_t)l * D * FF, D, FF, 0, D, (bf16*)(p.ws + WS_W2) + (size_t)l * D * FF, 0, scr, r / 32, r % 32, lane);
    }
}
__device__ __forceinline__ void phase0(const Params& p, LAS unsigned char* lds) {
    const int lane = otid() & 63, w = otid() >> 6, gw = obid() * 8 + w, ngw = gridDim.x * 8;
    convert_weights(p, 0, (LAS float*)(lds + w * 16384), gw, ngw, lane, 1);
    ln_phase(p.x, nullptr, (bf16*)(p.ws + WS_XN), p.ln_in_g, p.ln_in_b);
}

__device__ __forceinline__ void ab_phase(unsigned char* ws, size_t woff) {
    const int lane = otid() & 63, grp = obid() * 8 + (otid() >> 6);
    if (grp < M / 16) {
        const bf16* wb = (const bf16*)(ws + woff) + (size_t)(lane & 15) * D + 8 * (lane >> 4);
        const bf16* xa = (const bf16*)(ws + WS_XN) + (size_t)(16 * grp + (lane & 15)) * D + 8 * (lane >> 4);
        f32x4 acc = {0.f, 0.f, 0.f, 0.f};
#pragma unroll 1
        for (int k8 = 0; k8 < 4; ++k8) {
            bf16x8 a[8], b[8];
#pragma unroll
            for (int j = 0; j < 8; ++j) { a[j] = *(const bf16x8*)(xa + 32 * (8 * k8 + j)); b[j] = *(const bf16x8*)(wb + 32 * (8 * k8 + j)); }
#pragma unroll
            for (int j = 0; j < 8; ++j) acc = MFMA16(a[j], b[j], acc);
        }
        float* AB = (float*)(ws + WS_AB) + (size_t)(16 * grp + 4 * (lane >> 4)) * 16 + (lane & 15);
        AB[0] = acc[0]; AB[16] = acc[1]; AB[32] = acc[2]; AB[48] = acc[3];
    }
}
__device__ __forceinline__ void prep_phase(const Params& p, int layer, LAS unsigned char* lds, int mode = 7) {
    const int tid = otid(), lane = tid & 63, w = tid >> 6;
    LAS bf16* Qs = (LAS bf16*)lds;
    LAS bf16* Ks = Qs + 64 * 136;
    LAS bf16* Vs = Ks + 64 * 136;
    LAS float* gcs = (LAS float*)(lds + 3 * 64 * 136 * 2);
    LAS float* bts = gcs + 128;
    const float* convw = p.conv_w + (size_t)layer * 5 * 1536;
    const bf16* HG = (const bf16*)(p.ws + WS_HG);
    const float* AB = (const float*)(p.ws + WS_AB);
    float* Amat = (float*)((unsigned char*)p.out + OUT_MIX);
    bf16* recq = (bf16*)(p.ws + WS_RQ); bf16* reck = (bf16*)(p.ws + WS_RK); bf16* recv = (bf16*)(p.ws + WS_RV);
    bf16* recti = (bf16*)(p.ws + WS_RTI); bf16* recqk = (bf16*)(p.ws + WS_RQK); float* recvec = (float*)(p.ws + WS_VEC);
    int nit = 0;
    for (int item = obid(); item < 2048; item += gridDim.x, ++nit) {
        if (!(mode & 5)) continue;
        const int b = item >> 9, h = (item >> 7) & 3, n = item & 127;
        const int m0 = b * T + 64 * n;
        if (mode & 1) {
        if (w < 2) {
            const int dir = w, r = lane, c = dir ? 63 - r : r, m = m0 + c;
            const float a = AB[(size_t)m * 16 + dir * 4 + h], bb = AB[(size_t)m * 16 + 8 + dir * 4 + h];
            const float Aa = expf(p.a_log[layer * 8 + dir * 4 + h]);
            const float xx = a + p.dt_bias[layer * 8 + dir * 4 + h];
            const float sp = xx > 20.f ? xx : log1pf(expf(xx));
            const float g = -Aa * sp, beta = 1.f / (1.f + expf(-bb));
            float gc = g;
#pragma unroll
            for (int o = 1; o < 64; o <<= 1) { const float t = __shfl_up(gc, o); if (lane >= o) gc += t; }
            const float gl = __shfl(gc, 63);
            gcs[dir * 64 + r] = gc; bts[dir * 64 + r] = beta;
            float* vec = recvec + (size_t)(item * 2 + dir) * 256;
            vec[r] = expf(gc); vec[64 + r] = beta; vec[128 + r] = expf(gl - gc); if (r == 0) vec[192] = expf(gl);
        }
#pragma unroll
        for (int s = 0; s < 3; ++s) {
            const int col = s * 512 + h * 128 + 2 * lane;
            float w0[5], w1[5];
#pragma unroll
            for (int i = 0; i < 5; ++i) { w0[i] = convw[i * 1536 + col]; w1[i] = convw[i * 1536 + col + 1]; }
            float x0[12], x1[12];
#pragma unroll
            for (int i = 0; i < 12; ++i) {
                const int tl = 64 * n + 8 * w - 2 + i;
                unsigned u = 0u;
                if (tl >= 0 && tl < T) u = *(const unsigned*)(HG + (size_t)(b * T + tl) * 1536 + col);
                x0[i] = bflo(u); x1[i] = bfhi(u);
            }
            LAS bf16* dst = (s == 0) ? Qs : (s == 1 ? Ks : Vs);
            const int pos = (s < 2) ? ppos(2 * lane) : 2 * lane;
#pragma unroll
            for (int c8 = 0; c8 < 8; ++c8) {
                float y0 = 0.f, y1 = 0.f;
#pragma unroll
                for (int i = 0; i < 5; ++i) { y0 += w0[i] * x0[c8 + i]; y1 += w1[i] * x1[c8 + i]; }
                y0 = y0 * __builtin_amdgcn_rcpf(1.f + __expf(-y0)); y1 = y1 * __builtin_amdgcn_rcpf(1.f + __expf(-y1));
                if (s < 2) {
                    const float ss = wave_sum(y0 * y0 + y1 * y1);
                    float inv = __builtin_amdgcn_rsqf(ss + 1e-6f);
                    if (s == 0) inv *= 0.08838834764831845f;
                    y0 *= inv; y1 *= inv;
                }
                *(LAS unsigned*)(dst + (8 * w + c8) * 136 + pos) = pk2(y0, y1);
            }
        }
        }
        LDS_BARRIER();
        if (mode & 4) {
        {
            bf16* qr = recq + (size_t)item * 8192; bf16* kr = reck + (size_t)item * 8192; bf16* vr = recv + (size_t)item * 8192;
            for (int ch = tid; ch < 1024; ch += 512) {
                const int r = ch >> 4, cc = ch & 15;
                *(u32x4*)(qr + r * 128 + cc * 8) = *(const LAS u32x4*)(Qs + r * 136 + cc * 8);
                *(u32x4*)(kr + r * 128 + cc * 8) = *(const LAS u32x4*)(Ks + r * 136 + cc * 8);
            }
            const int v = tid & 127;
            for (int cgp = tid >> 7; cgp < 8; cgp += 4) {
                const int c0 = 8 * cgp; unsigned short e[8];
#pragma unroll
                for (int k = 0; k < 8; ++k) e[k] = Vs[(c0 + k) * 136 + v];
                u32x4 o; o.x = e[0] | ((unsigned)e[1] << 16); o.y = e[2] | ((unsigned)e[3] << 16); o.z = e[4] | ((unsigned)e[5] << 16); o.w = e[6] | ((unsigned)e[7] << 16);
                *(u32x4*)(vr + v * 64 + c0) = o;
            }
        }
        {
            int lo_ = lane; asm volatile("" : "+v"(lo_));
            const int mat = w >> 2, ti = (w >> 1) & 1, tj = w & 1, l31 = lo_ & 31, h2 = lo_ >> 5;
            const LAS bf16* X = mat ? Qs : Ks;
            f32x16 acc;
#pragma unroll
            for (int r = 0; r < 16; ++r) acc[r] = 0.f;
#pragma unroll
            for (int s = 0; s < 8; ++s) {
                const bf16x8 a = *(const LAS bf16x8*)(Ks + (32 * tj + l31) * 136 + 16 * s + 8 * h2);
                const bf16x8 bb = *(const LAS bf16x8*)(X + (32 * ti + l31) * 136 + 16 * s + 8 * h2);
                acc = MFMA32(a, bb, acc);
            }
            const int i = 32 * ti + l31;
#pragma unroll
            for (int dir = 0; dir < 2; ++dir) {
                const int ri = dir ? 63 - i : i; const float gci = gcs[dir * 64 + ri], bti = bts[dir * 64 + ri];
                const size_t id = (size_t)(item * 2 + dir);
#pragma unroll
                for (int q = 0; q < 4; ++q) {
                    const int j0 = 32 * tj + 8 * q + 4 * h2;
                    const int rj0 = dir ? 60 - j0 : j0;
                    const f32x4 gq = *(const LAS f32x4*)(gcs + dir * 64 + rj0);
                    f32x4 val;
#pragma unroll
                    for (int e = 0; e < 4; ++e) {
                        const int rj = rj0 + e;
                        const float a = acc[4 * q + (dir ? 3 - e : e)];
                        const float ex = __expf(fminf(gci - gq[e], 0.f));
                        val[e] = (mat == 0) ? ((rj < ri) ? bti * a * ex : 0.f) : ((rj <= ri) ? a * ex : 0.f);
                    }
                    if (mat == 0) *(f32x4*)(Amat + id * 4096 + ri * 64 + rj0) = val;
                    else { u32x2 wv; wv.x = pk2(val[0], val[1]); wv.y = pk2(val[2], val[3]); *(u32x2*)(recqk + id * 4096 + ri * 64 + ppos(rj0)) = wv; }
                }
            }
        }
        }
        LDS_BARRIER();
    }
    __syncthreads();
    {

        for (int sidx = w; sidx < ((mode & 2) ? 2 * nit : 0); sidx += 8) {
            const int item = obid() + (sidx >> 1) * gridDim.x, dir = sidx & 1;
            const size_t id = (size_t)(item * 2 + dir);
            const float* Ag = Amat + id * 4096;
            float x[64];
            const float lanef = (float)lane;
            float rowv[8];
#pragma unroll
            for (int q = 0; q < 8; ++q) rowv[q] = Ag[q * 64 + lane];
#pragma unroll
            for (int i = 0; i < 64; ++i) {
                const float rv = rowv[i & 7];
                if (i + 8 < 64) rowv[i & 7] = Ag[(i + 8) * 64 + lane];
                float a0 = fmaxf(1.f - fabsf(lanef - (float)i), 0.f), a1 = 0.f, a2 = 0.f, a3 = 0.f;
#pragma unroll
                for (int j = 0; j < i; ++j) {
                    const float s = __builtin_bit_cast(float, __builtin_amdgcn_readlane(__builtin_bit_cast(int, rv), j));
                    if ((j & 3) == 0) a0 = fmaf(-s, x[j], a0); else if ((j & 3) == 1) a1 = fmaf(-s, x[j], a1); else if ((j & 3) == 2) a2 = fmaf(-s, x[j], a2); else a3 = fmaf(-s, x[j], a3);
                }
                x[i] = (a0 + a1) + (a2 + a3);
            }
            bf16* tr = recti + id * 4096; const int pos = ppos(lane);
#pragma unroll
            for (int i = 0; i < 64; ++i) tr[i * 64 + pos] = f2bf(x[i]);
        }
    }
}

constexpr int SC_BUF = 72704, SC_Q = 0, SC_K = 17408, SC_TI = 34816, SC_QK = 44032, SC_VEC = 53248, SC_V = 54272;
struct ScanRegs { u32x4 rq[4], rk[4], rt[2], rqk[2], rvv[4]; float rv; };
template <int dir> __device__ __forceinline__ void scan_fetch(const Params& p, int b, int h, int n, int lt, ScanRegs& R) {
    const int nt = dir ? 127 - n : n; const size_t item = (size_t)((b * 4 + h) * 128 + nt); const size_t id = item * 2 + dir;
    const bf16* qr = (const bf16*)(p.ws + WS_RQ) + item * 8192; const bf16* kr = (const bf16*)(p.ws + WS_RK) + item * 8192;
    const bf16* tr = (const bf16*)(p.ws + WS_RTI) + id * 4096; const bf16* qk = (const bf16*)(p.ws + WS_RQK) + id * 4096;
    const float* vec = (const float*)(p.ws + WS_VEC) + id * 256;
    const bf16* vt = (const bf16*)(p.ws + WS_RV) + item * 8192;
#pragma unroll
    for (int i = 0; i < 4; ++i) { const int ch = lt + 256 * i; R.rvv[i] = *(const u32x4*)(vt + ch * 8); }
#pragma unroll
    for (int i = 0; i < 4; ++i) { const int ch = lt + 256 * i, r = ch >> 4, cc = ch & 15, sr = dir ? 63 - r : r; R.rq[i] = *(const u32x4*)(qr + sr * 128 + cc * 8); R.rk[i] = *(const u32x4*)(kr + sr * 128 + cc * 8); }
#pragma unroll
    for (int i = 0; i < 2; ++i) { const int ch = lt + 256 * i, r = ch >> 3, cc = ch & 7; R.rt[i] = *(const u32x4*)(tr + r * 64 + cc * 8); R.rqk[i] = *(const u32x4*)(qk + r * 64 + cc * 8); }
    R.rv = (lt < 193) ? vec[lt] : 0.f;
}
__device__ __forceinline__ void scan_store(LAS unsigned char* buf, int lt, const ScanRegs& R) {
#pragma unroll
    for (int i = 0; i < 4; ++i) { const int ch = lt + 256 * i, r = ch >> 4, cc = ch & 15; *(LAS u32x4*)(buf + SC_Q + (r * 136 + cc * 8) * 2) = R.rq[i]; *(LAS u32x4*)(buf + SC_K + (r * 136 + cc * 8) * 2) = R.rk[i]; }
#pragma unroll
    for (int i = 0; i < 2; ++i) { const int ch = lt + 256 * i, r = ch >> 3, cc = ch & 7; *(LAS u32x4*)(buf + SC_TI + (r * 72 + cc * 8) * 2) = R.rt[i]; *(LAS u32x4*)(buf + SC_QK + (r * 72 + cc * 8) * 2) = R.rqk[i]; }
    *(LAS float*)(buf + SC_VEC + lt * 4) = R.rv;
#pragma unroll
    for (int i = 0; i < 4; ++i) { const int ch = lt + 256 * i, v = ch >> 3, cc = ch & 7; *(LAS u32x4*)(buf + SC_V + v * 144 + cc * 16) = R.rvv[i]; }
}
template <int dir, int smode = 7> __device__ __forceinline__ void scan_chain(const Params& p, int layer, LAS unsigned char* lds, int chain) {
    const int tid = otid(), lane = tid & 63, w = __builtin_amdgcn_readfirstlane(tid >> 6);
    const int half = chain & 1; chain >>= 1;
    const int b = chain >> 3, h = (chain >> 1) & 3;
    const int l31 = lane & 31, h2 = lane >> 5, vcol = 64 * half + 32 * (w & 1) + l31;
    bf16* og = (bf16*)(p.ws + WS_HG) + (size_t)dir * M * 512;
    if (w >= 4) {
        if (!(smode & 1)) { LDS_BARRIER(); for (int n = 0; n < 128; ++n) LDS_BARRIER(); return; }
        ScanRegs R0, R1;
        scan_fetch<dir>(p, b, h, 0, tid - 256, R0); scan_store(lds, tid - 256, R0); scan_fetch<dir>(p, b, h, 1, tid - 256, R0); scan_fetch<dir>(p, b, h, 2, tid - 256, R1);
        LDS_BARRIER();
#pragma unroll 1
        for (int n = 0; n < 128; n += 2) {
            scan_store(lds + SC_BUF, tid - 256, R0);
            if (n + 3 < 128) scan_fetch<dir>(p, b, h, n + 3, tid - 256, R0);
            LDS_BARRIER();
            if (n + 2 < 128) scan_store(lds, tid - 256, R1);
            if (n + 4 < 128) scan_fetch<dir>(p, b, h, n + 4, tid - 256, R1);
            LDS_BARRIER();
        }
    } else if (w >= 2) {
        LDS_BARRIER();
#pragma unroll 1
        for (int n = 0; n < 128; ++n) LDS_BARRIER();
    } else {
        if (!(smode & 2)) { LDS_BARRIER(); for (int n = 0; n < 128; ++n) LDS_BARRIER(); return; }
        f32x16 S[4];
#pragma unroll
        for (int k = 0; k < 4; ++k)
#pragma unroll
            for (int r = 0; r < 16; ++r) S[k][r] = 0.f;
        LDS_BARRIER();
#pragma unroll 1
        for (int n = 0; n < 128; ++n) {
            const LAS unsigned char* buf = lds + (n & 1) * SC_BUF;
            const LAS bf16* Qp = (const LAS bf16*)(buf + SC_Q); const LAS bf16* Kp = (const LAS bf16*)(buf + SC_K);
            const LAS bf16* Ti = (const LAS bf16*)(buf + SC_TI); const LAS bf16* QKm = (const LAS bf16*)(buf + SC_QK);
            const LAS float* vecl = (const LAS float*)(buf + SC_VEC);
            const float gl = vecl[192];
            bf16x8 Sb[8];
#pragma unroll
            for (int kt = 0; kt < 4; ++kt)
#pragma unroll
                for (int s = 0; s < 2; ++s) Sb[2 * kt + s] = pack8(S[kt][8 * s + 0], S[kt][8 * s + 1], S[kt][8 * s + 2], S[kt][8 * s + 3], S[kt][8 * s + 4], S[kt][8 * s + 5], S[kt][8 * s + 6], S[kt][8 * s + 7]);
            SBAR;
            f32x16 kA, kB;
#pragma unroll
            for (int r = 0; r < 16; ++r) { kA[r] = 0.f; kB[r] = 0.f; }
#pragma unroll
            for (int hf = 0; hf < 2; ++hf) {
                bf16x8 f0[4], f1[4];
#pragma unroll
                for (int k4 = 0; k4 < 4; ++k4) {
                    f0[k4] = *(const LAS bf16x8*)(Kp + (l31) * 136 + 16 * (4 * hf + k4) + 8 * h2);
                    f1[k4] = *(const LAS bf16x8*)(Kp + (32 + l31) * 136 + 16 * (4 * hf + k4) + 8 * h2);
                }
                SBAR;
#pragma unroll
                for (int k4 = 0; k4 < 4; ++k4) { kA = MFMA32(f0[k4], Sb[4 * hf + k4], kA); kB = MFMA32(f1[k4], Sb[4 * hf + k4], kB); }
                SBAR;
            }
            f32x16 qA, qB;
#pragma unroll
            for (int r = 0; r < 16; ++r) { qA[r] = 0.f; qB[r] = 0.f; }
            bf16x8 tb[4];
#pragma unroll
            for (int pt = 0; pt < 4; ++pt) {
                const int mt = pt >> 1, s = pt & 1;
                bf16x8 f0[2], f1[2];
#pragma unroll
                for (int k2 = 0; k2 < 2; ++k2) {
                    f0[k2] = *(const LAS bf16x8*)(Qp + (l31) * 136 + 16 * (2 * pt + k2) + 8 * h2);
                    f1[k2] = *(const LAS bf16x8*)(Qp + (32 + l31) * 136 + 16 * (2 * pt + k2) + 8 * h2);
                }
                f32x4 eg[2], bt[2]; u32x2 vq[2];
#pragma unroll
                for (int qq = 0; qq < 2; ++qq) {
                    const int q = 2 * s + qq;
                    eg[qq] = *(const LAS f32x4*)(vecl + 32 * mt + 8 * q + 4 * h2); bt[qq] = *(const LAS f32x4*)(vecl + 64 + 32 * mt + 8 * q + 4 * h2);
                    vq[qq] = *(const LAS u32x2*)(buf + SC_V + vcol * 144 + (dir ? 60 - (32 * mt + 8 * q + 4 * h2) : (32 * mt + 8 * q + 4 * h2)) * 2);
                }
                SBAR;
#pragma unroll
                for (int k2 = 0; k2 < 2; ++k2) { qA = MFMA32(f0[k2], Sb[2 * pt + k2], qA); qB = MFMA32(f1[k2], Sb[2 * pt + k2], qB); }
                float t8[8];
#pragma unroll
                for (int qq = 0; qq < 2; ++qq) {
                    const u32x2 u = vq[qq];
                    const float e0 = bflo(u.x), e1 = bfhi(u.x), e2 = bflo(u.y), e3 = bfhi(u.y);
                    f32x4 vv; vv[0] = dir ? e3 : e0; vv[1] = dir ? e2 : e1; vv[2] = dir ? e1 : e2; vv[3] = dir ? e0 : e3;
#pragma unroll
                    for (int e = 0; e < 4; ++e) { const float ksv = mt ? kB[8 * s + 4 * qq + e] : kA[8 * s + 4 * qq + e]; t8[4 * qq + e] = bt[qq][e] * (vv[e] - eg[qq][e] * ksv); }
                }
                tb[pt] = pack8(t8[0], t8[1], t8[2], t8[3], t8[4], t8[5], t8[6], t8[7]);
#pragma unroll
                for (int g = 0; g < 4; ++g) { __builtin_amdgcn_sched_group_barrier(0x8, 1, 0); __builtin_amdgcn_sched_group_barrier(0x2, 9, 0); }
                SBAR;
            }
            f32x16 vA, vB;
#pragma unroll
            for (int r = 0; r < 16; ++r) { vA[r] = 0.f; vB[r] = 0.f; }
            {
                bf16x8 f0[4], f1[4];
#pragma unroll
                for (int ks = 0; ks < 4; ++ks) {
                    f0[ks] = *(const LAS bf16x8*)(Ti + (l31) * 72 + 16 * ks + 8 * h2);
                    f1[ks] = *(const LAS bf16x8*)(Ti + (32 + l31) * 72 + 16 * ks + 8 * h2);
                }
                f32x4 egA[4], egB[4];
#pragma unroll
                for (int q = 0; q < 4; ++q) { egA[q] = *(const LAS f32x4*)(vecl + 8 * q + 4 * h2); egB[q] = *(const LAS f32x4*)(vecl + 32 + 8 * q + 4 * h2); }
                SBAR;
#pragma unroll
                for (int ks = 0; ks < 4; ++ks) { vA = MFMA32(f0[ks], tb[ks], vA); vB = MFMA32(f1[ks], tb[ks], vB); }
#pragma unroll
                for (int q = 0; q < 4; ++q)
#pragma unroll
                    for (int e = 0; e < 4; ++e) { qA[4 * q + e] *= egA[q][e]; qB[4 * q + e] *= egB[q][e]; }
#pragma unroll
                for (int kt = 0; kt < 4; ++kt)
#pragma unroll
                    for (int r = 0; r < 16; ++r) S[kt][r] *= gl;
#pragma unroll
                for (int g = 0; g < 8; ++g) { __builtin_amdgcn_sched_group_barrier(0x8, 1, 0); __builtin_amdgcn_sched_group_barrier(0x2, 6, 0); }
                SBAR;
            }
            bf16x8 vb[4], vsb[4];
            {
                f32x4 ekA[4], ekB[4];
#pragma unroll
                for (int q = 0; q < 4; ++q) { ekA[q] = *(const LAS f32x4*)(vecl + 128 + 8 * q + 4 * h2); ekB[q] = *(const LAS f32x4*)(vecl + 128 + 32 + 8 * q + 4 * h2); }
#pragma unroll
                for (int s = 0; s < 2; ++s) {
                    vb[s] = pack8(vA[8 * s + 0], vA[8 * s + 1], vA[8 * s + 2], vA[8 * s + 3], vA[8 * s + 4], vA[8 * s + 5], vA[8 * s + 6], vA[8 * s + 7]);
                    vb[2 + s] = pack8(vB[8 * s + 0], vB[8 * s + 1], vB[8 * s + 2], vB[8 * s + 3], vB[8 * s + 4], vB[8 * s + 5], vB[8 * s + 6], vB[8 * s + 7]);
                    vsb[s] = pack8(ekA[2 * s][0] * vA[8 * s + 0], ekA[2 * s][1] * vA[8 * s + 1], ekA[2 * s][2] * vA[8 * s + 2], ekA[2 * s][3] * vA[8 * s + 3], ekA[2 * s + 1][0] * vA[8 * s + 4], ekA[2 * s + 1][1] * vA[8 * s + 5], ekA[2 * s + 1][2] * vA[8 * s + 6], ekA[2 * s + 1][3] * vA[8 * s + 7]);
                    vsb[2 + s] = pack8(ekB[2 * s][0] * vB[8 * s + 0], ekB[2 * s][1] * vB[8 * s + 1], ekB[2 * s][2] * vB[8 * s + 2], ekB[2 * s][3] * vB[8 * s + 3], ekB[2 * s + 1][0] * vB[8 * s + 4], ekB[2 * s + 1][1] * vB[8 * s + 5], ekB[2 * s + 1][2] * vB[8 * s + 6], ekB[2 * s + 1][3] * vB[8 * s + 7]);
                }
            }
            SBAR;
            {
                const int g4 = lane >> 4, i16 = lane & 15, q4 = i16 >> 2, pp = i16 & 3, pq = ((pp & 1) << 1) | (pp >> 1);
                const LAS bf16* kb0 = Kp + (4 * h2 + q4) * 136 + 16 * (g4 & 1) + 4 * pq;
                const int nt = dir ? 127 - n : n;
                bf16* ob = og + (size_t)(b * T + 64 * nt) * 512 + h * 128 + vcol;
                s16x4 lo0[4], hi0[4], lo1[4], hi1[4];
#pragma unroll
                for (int ks = 0; ks < 4; ++ks) {
                    lo0[ks] = trread(kb0 + (16 * ks) * 136); hi0[ks] = trread(kb0 + (16 * ks + 8) * 136);
                    lo1[ks] = trread(kb0 + (16 * ks) * 136 + 32); hi1[ks] = trread(kb0 + (16 * ks + 8) * 136 + 32);
                }
                bf16x8 f0[4], f1[4];
#pragma unroll
                for (int ks = 0; ks < 4; ++ks) {
                    f0[ks] = *(const LAS bf16x8*)(QKm + (l31) * 72 + 16 * ks + 8 * h2);
                    f1[ks] = *(const LAS bf16x8*)(QKm + (32 + l31) * 72 + 16 * ks + 8 * h2);
                }
                SBAR;
#pragma unroll
                for (int ks = 0; ks < 4; ++ks) {
                    S[0] = MFMA32(cat8(lo0[ks], hi0[ks]), vsb[ks], S[0]);
                    S[1] = MFMA32(cat8(lo1[ks], hi1[ks]), vsb[ks], S[1]);
                }
#pragma unroll
                for (int ks = 0; ks < 4; ++ks) { qA = MFMA32(f0[ks], vb[ks], qA); qB = MFMA32(f1[ks], vb[ks], qB); }
                SBAR;
#pragma unroll
                for (int ks = 0; ks < 4; ++ks) {
                    lo0[ks] = trread(kb0 + (16 * ks) * 136 + 64); hi0[ks] = trread(kb0 + (16 * ks + 8) * 136 + 64);
                    lo1[ks] = trread(kb0 + (16 * ks) * 136 + 96); hi1[ks] = trread(kb0 + (16 * ks + 8) * 136 + 96);
                }
                SBAR;
#pragma unroll
                for (int ks = 0; ks < 4; ++ks) {
                    S[2] = MFMA32(cat8(lo0[ks], hi0[ks]), vsb[ks], S[2]);
                    S[3] = MFMA32(cat8(lo1[ks], hi1[ks]), vsb[ks], S[3]);
                }
                const int odd = lane & 1;
                bf16* obo = ob + (odd ? (dir ? -512 : 512) - 1 : 0);
#pragma unroll
                for (int mt = 0; mt < 2; ++mt)
#pragma unroll
                    for (int q = 0; q < 4; ++q)
#pragma unroll
                        for (int ep = 0; ep < 2; ++ep) {
                            const float x = mt ? qB[4 * q + 2 * ep] : qA[4 * q + 2 * ep], y = mt ? qB[4 * q + 2 * ep + 1] : qA[4 * q + 2 * ep + 1];
                            const float snd = odd ? x : y;
                            const float rcv = __builtin_bit_cast(float, __builtin_amdgcn_mov_dpp(__builtin_bit_cast(int, snd), 0xB1, 0xF, 0xF, true));
                            const unsigned pk = odd ? pk2(rcv, y) : pk2(x, rcv);
                            const int r = 32 * mt + 8 * q + 4 * h2 + 2 * ep; const int c = dir ? 63 - r : r;
                            if (smode & 4) *(unsigned*)(obo + (ptrdiff_t)c * 512) = pk;
                        }
                SBAR;
            }
            LDS_BARRIER();
        }
    }
}

__device__ __forceinline__ void na_items(const Params& p, int layer, LAS unsigned char* lds, int widx, int wstride) {
    const int lane = otid() & 63, w = otid() >> 6;
    const int fr = lane & 15, fq = lane >> 4;
    const LAS float* rp = (const LAS float*)lds;
    LAS bf16* Vst = (LAS bf16*)(lds + 16384 + w * 5120);
    const bf16* HN = (const bf16*)(p.ws + WS_HN);
    bf16* MIX = (bf16*)((unsigned char*)p.out + OUT_MIX);
    const float* ng = p.na_norm_g + layer * 64;
    for (int it = widx; it < 16384; it += wstride) {
        const int hh = it & 7, j = (it >> 3) & 3, r = (it >> 5) & 127, b = it >> 12;
        int r0 = r - 4; r0 = r0 < 0 ? 0 : (r0 > 120 ? 120 : r0);
        int ss = 16 * j - 8; ss = ss < 0 ? 0 : (ss > 32 ? 32 : ss);
        const int qc = 16 * j + fr;
        int wsn = qc - 8; wsn = wsn < 0 ? 0 : (wsn > 48 ? 48 : wsn);
        const size_t mq = (size_t)b * T + r * 64 + qc;
        bf16x8 Qf[2];
#pragma unroll
        for (int ks = 0; ks < 2; ++ks) Qf[ks] = *(const bf16x8*)(HN + mq * 1536 + hh * 64 + 32 * ks + 8 * fq);
        u32x4 vr[4][4];
#pragma unroll
        for (int i = 0; i < 4; ++i)
#pragma unroll
            for (int m4 = 0; m4 < 4; ++m4) {
                const int idx = lane + 64 * m4, key = idx >> 3, chn = idx & 7;
                const size_t mk = (size_t)b * T + (r0 + i) * 64 + ss + key;
                vr[i][m4] = *(const u32x4*)(HN + mk * 1536 + 1024 + hh * 64 + 8 * chn);
            }
        f32x4 sc[8][2];
#pragma unroll
        for (int i = 0; i < 8; ++i)
#pragma unroll
            for (int t = 0; t < 2; ++t) {
                const size_t mk = (size_t)b * T + (r0 + i) * 64 + ss + 16 * t + fr;
                const bf16x8 k0 = *(const bf16x8*)(HN + mk * 1536 + 512 + hh * 64 + 8 * fq);
                const bf16x8 k1 = *(const bf16x8*)(HN + mk * 1536 + 512 + hh * 64 + 32 + 8 * fq);
                f32x4 a = {0.f, 0.f, 0.f, 0.f};
                a = MFMA16(k0, Qf[0], a); a = MFMA16(k1, Qf[1], a);
                sc[i][t] = a;
            }
        float mx = -INFINITY;
#pragma unroll
        for (int i = 0; i < 8; ++i) {
            const int dr = r0 + i - r + 7;
            const LAS float* rb = rp + (hh * 15 + dr) * 31;
#pragma unroll
            for (int t = 0; t < 2; ++t)
#pragma unroll
                for (int e = 0; e < 4; ++e) {
                    const int kc = ss + 16 * t + 4 * fq + e;
                    int rel = kc - qc + 15; rel = rel < 0 ? 0 : (rel > 30 ? 30 : rel);
                    const bool valid = (kc >= wsn) && (kc < wsn + 16);
                    const float s = valid ? (sc[i][t][e] * 0.125f + rb[rel]) : -INFINITY;
                    sc[i][t][e] = s; mx = fmaxf(mx, s);
                }
        }
        mx = fmaxf(mx, __shfl_xor(mx, 16)); mx = fmaxf(mx, __shfl_xor(mx, 32));
        float sum = 0.f;
#pragma unroll
        for (int i = 0; i < 8; ++i)
#pragma unroll
            for (int t = 0; t < 2; ++t)
#pragma unroll
                for (int e = 0; e < 4; ++e) { const float pe = __expf(sc[i][t][e] - mx); sc[i][t][e] = pe; sum += pe; }
        sum += __shfl_xor(sum, 16); sum += __shfl_xor(sum, 32);
        f32x4 O[4];
#pragma unroll
        for (int dt = 0; dt < 4; ++dt) O[dt] = (f32x4){0.f, 0.f, 0.f, 0.f};
#pragma unroll
        for (int i = 0; i < 8; ++i) {
            WAVE_SYNC();
#pragma unroll
            for (int m4 = 0; m4 < 4; ++m4) { const int idx = lane + 64 * m4, key = idx >> 3, chn = idx & 7; *(LAS u32x4*)(Vst + key * 80 + chn * 8) = vr[i & 3][m4]; }
            if (i + 4 < 8) {
#pragma unroll
                for (int m4 = 0; m4 < 4; ++m4) {
                    const int idx = lane + 64 * m4, key = idx >> 3, chn = idx & 7;
                    const size_t mk = (size_t)b * T + (r0 + i + 4) * 64 + ss + key;
                    vr[i & 3][m4] = *(const u32x4*)(HN + mk * 1536 + 1024 + hh * 64 + 8 * chn);
                }
            }
            WAVE_SYNC();
            const f32x4 p0 = sc[i][0], p1 = sc[i][1];
            const bf16x8 Pf = pack8(p0[0], p0[1], p0[2], p0[3], p1[0], p1[1], p1[2], p1[3]);
            const int q4 = fr >> 2, pp = fr & 3;
#pragma unroll
            for (int dt = 0; dt < 4; ++dt) {
                const s16x4 lo = trread(Vst + (4 * fq + q4) * 80 + 16 * dt + 4 * pp);
                const s16x4 hi = trread(Vst + (16 + 4 * fq + q4) * 80 + 16 * dt + 4 * pp);
                O[dt] = MFMA16(Pf, cat8(lo, hi), O[dt]);
            }
        }
#pragma unroll
        for (int e = 0; e < 4; ++e) {
            const float sm = __shfl(sum, 4 * fq + e);
            const float inv = 1.0f / sm;
            float o0 = O[0][e] * inv, o1 = O[1][e] * inv, o2 = O[2][e] * inv, o3 = O[3][e] * inv;
            float ssq = o0 * o0 + o1 * o1 + o2 * o2 + o3 * o3;
            ssq += __shfl_xor(ssq, 1); ssq += __shfl_xor(ssq, 2); ssq += __shfl_xor(ssq, 4); ssq += __shfl_xor(ssq, 8);
            const float rs = 1.0f / sqrtf(ssq * (1.f / 64.f) + 1e-6f);
            const size_t mo = (size_t)b * T + r * 64 + 16 * j + 4 * fq + e;
            bf16* dst = MIX + mo * 1024 + 512 + hh * 64 + fr;
            dst[0] = f2bf(o0 * rs * ng[fr]); dst[16] = f2bf(o1 * rs * ng[16 + fr]); dst[32] = f2bf(o2 * rs * ng[32 + fr]); dst[48] = f2bf(o3 * rs * ng[48 + fr]);
        }
    }
}
template <int smode = 7> __device__ __forceinline__ void scan_na_phase(const Params& p, int layer, LAS unsigned char* lds, int mode = 3) {
    if (obid() < NSCAN) {
#if !defined(MK_NO_SCAN)
        if (!(mode & 1)) {} else if (obid() & 2) scan_chain<1, smode>(p, layer, lds, obid()); else scan_chain<0, smode>(p, layer, lds, obid());
#endif
    }
    else {
        const float* rpb = p.rpb + (size_t)layer * 8 * 15 * 31;
        for (int i = otid(); i < 8 * 15 * 31; i += 512) ((LAS float*)lds)[i] = rpb[i];
        __syncthreads();
#if !defined(MK_NO_NA)
        if (mode & 2) na_items(p, layer, lds, (obid() - NSCAN) * 8 + (otid() >> 6), ((int)gridDim.x - NSCAN) * 8);
        if ((mode & 2) && layer == 0 && smode == 7) {
            LAS float* scr = (LAS float*)(lds + 65536 + (otid() >> 6) * 8704); const int gw = (obid() - NSCAN) * 8 + (otid() >> 6), ngw = ((int)gridDim.x - NSCAN) * 8;
            convert_weights(p, 0, scr, gw, ngw, otid() & 63, 2);
            convert_weights(p, 1, scr, gw, ngw, otid() & 63, 3);
        }
        if ((mode & 2) && smode == 7) {
            __syncthreads();
            pg8::Gemm gz{(const bf16*)(p.ws + WS_XN), (const bf16*)(p.ws + WS_WIN) + (size_t)layer * NIN * D + (size_t)3328 * D, M, 512, D};
            pg8::StaticOrder Sz; Sz.init(M, 512, (int)gridDim.x - NSCAN, obid() - NSCAN);
            EpiIn Ez{(bf16*)(p.ws + WS_HG), (bf16*)(p.ws + WS_HZ), (bf16*)(p.ws + WS_HN), (float*)(p.ws + WS_AB), 13};
            pg8::gemm_phase<EpiIn, pg8::StaticOrder, true, true>(lds, gz, Sz, Ez);
        }
#endif
    }
}

__device__ __forceinline__ void combine_phase(const Params& p, int layer) {
    const int lane = otid() & 63, gw = obid() * 8 + (otid() >> 6), ngw = gridDim.x * 8;
    const bf16* og = (const bf16*)(p.ws + WS_HG); const bf16* HZ = (const bf16*)(p.ws + WS_HZ); bf16* MIX = (bf16*)((unsigned char*)p.out + OUT_MIX);
    const float* g = p.gdn_norm_g + layer * 128;
    const int col = 8 * lane;
    float gv[8];
#pragma unroll
    for (int k = 0; k < 8; ++k) gv[k] = g[(col & 127) + k];
    for (int m = gw; m < M; m += ngw) {
        const u32x4 a = *(const u32x4*)(og + (size_t)m * 512 + col), bq = *(const u32x4*)(og + (size_t)M * 512 + (size_t)m * 512 + col), z = *(const u32x4*)(HZ + (size_t)m * 512 + col);
        float o[8], zz[8];
#pragma unroll
        for (int k = 0; k < 4; ++k) { o[2 * k] = bflo(a[k]) + bflo(bq[k]); o[2 * k + 1] = bfhi(a[k]) + bfhi(bq[k]); zz[2 * k] = bflo(z[k]); zz[2 * k + 1] = bfhi(z[k]); }
        float ssq = 0.f;
#pragma unroll
        for (int k = 0; k < 8; ++k) ssq += o[k] * o[k];
        ssq += __shfl_xor(ssq, 1); ssq += __shfl_xor(ssq, 2); ssq += __shfl_xor(ssq, 4); ssq += __shfl_xor(ssq, 8);
        const float rs = 1.0f / sqrtf(ssq * (1.f / 128.f) + 1e-6f);
        float y[8];
#pragma unroll
        for (int k = 0; k < 8; ++k) { const float sz = zz[k] * __builtin_amdgcn_rcpf(1.f + __expf(-zz[k])); y[k] = o[k] * rs * gv[k] * sz; }
        u32x4 wv; wv.x = pk2(y[0], y[1]); wv.y = pk2(y[2], y[3]); wv.z = pk2(y[4], y[5]); wv.w = pk2(y[6], y[7]);
        *(u32x4*)(MIX + (size_t)m * 1024 + col) = wv;
    }
}

#define XB_TMO      128
#define XB_XCNT(j)  (256  + 64 * (j))
#define XB_XSUB(j)  (1280 + 64 * (j))
#define XB_XGEN(j)  (2304 + 64 * (j))
#define XB_TOP      3328
#define XB_TOPGEN   3392
#define XCD_BAR_WORDS 3456
#define XB_SPIN_CAP (1u << 18)

__device__ __forceinline__ unsigned xb_ld(unsigned* p)              { return __hip_atomic_load(p, __ATOMIC_RELAXED, __HIP_MEMORY_SCOPE_AGENT); }
__device__ __forceinline__ unsigned xb_add(unsigned* p, unsigned v) { return __hip_atomic_fetch_add(p, v, __ATOMIC_RELAXED, __HIP_MEMORY_SCOPE_AGENT); }
__device__ __forceinline__ unsigned xb_xcc_id() { return (unsigned)__builtin_amdgcn_s_getreg((3 << 11) | 20) & 0xFu; }
#define XB_SPIN(cond, bar) do { unsigned _sp = 0; while (cond) { __builtin_amdgcn_s_sleep(1); \
    if ((++_sp & 255u) == 0u) { if (xb_ld(&(bar)[XB_TMO])) break; if (_sp > XB_SPIN_CAP) { atomicAdd(&(bar)[XB_TMO], 1u); break; } } } } while (0)

struct XcdBarrier {
    unsigned* bar; unsigned x;
    volatile LAS unsigned* st;
};

__device__ __forceinline__ XcdBarrier xcd_barrier_post(unsigned* bar, volatile LAS unsigned* st) {
    XcdBarrier b; b.bar = bar; b.x = xb_xcc_id(); b.st = st;
    if (threadIdx.x == 0) (void)xb_add(&bar[XB_XCNT(b.x)], 1u);
    return b;
}
__device__ __forceinline__ void xcd_barrier_complete(unsigned* bar, unsigned x, unsigned& nloc, unsigned& nx) {
    const unsigned G = gridDim.x * gridDim.y * gridDim.z;
    unsigned sum, cnt, mine, sp = 0u;
    for (;;) {
        sum = 0u; cnt = 0u; mine = 0u;
#pragma unroll
        for (unsigned j = 0; j < 16; ++j) { const unsigned c = xb_ld(&bar[XB_XCNT(j)]); sum += c; cnt += (c > 0u) ? 1u : 0u; mine = (j == x) ? c : mine; }
        if (sum == G) break;
        __builtin_amdgcn_s_sleep(1);
        if ((++sp & 255u) == 0u) { if (xb_ld(&bar[XB_TMO])) break; if (sp > XB_SPIN_CAP) { atomicAdd(&bar[XB_TMO], 1u); break; } }
    }
    nloc = mine > 0u ? mine : 1u; nx = cnt > 0u ? cnt : 1u;
}

__device__ __forceinline__ void xcd_barrier(const XcdBarrier& b) {
    asm volatile("s_waitcnt vmcnt(0)" ::: "memory");
    __syncthreads();
    if (threadIdx.x == 0) {
        unsigned* bar = b.bar;
        __builtin_amdgcn_s_waitcnt(0);
        unsigned nloc = b.st[0], nx = b.st[1];
        if (nloc == 0u) { xcd_barrier_complete(bar, b.x, nloc, nx); b.st[0] = nloc; b.st[1] = nx; }
        const unsigned old = xb_add(&bar[XB_XSUB(b.x)], 1u);
        const unsigned gen = old / nloc;
        if (old + 1u == (gen + 1u) * nloc) {
            __builtin_amdgcn_fence(__ATOMIC_RELEASE, "agent");
            asm volatile("s_waitcnt vmcnt(0)" ::: "memory");
            const unsigned og = xb_add(&bar[XB_TOP], 1u);
            const unsigned tg = og / nx;
            if (og + 1u == (tg + 1u) * nx) xb_add(&bar[XB_TOPGEN], 1u);
            else XB_SPIN(xb_ld(&bar[XB_TOPGEN]) == tg, bar);
            __builtin_amdgcn_fence(__ATOMIC_ACQUIRE, "agent");
            xb_add(&bar[XB_XGEN(b.x)], 1u);
            asm volatile("s_waitcnt vmcnt(0)" ::: "memory");
        } else {
            XB_SPIN(xb_ld(&bar[XB_XGEN(b.x)]) == gen, bar);
            __builtin_amdgcn_fence(__ATOMIC_ACQUIRE, "agent");
            asm volatile("s_waitcnt vmcnt(0)" ::: "memory");
        }
    }
    __syncthreads();
}

typedef const __attribute__((address_space(4))) Params* KParamsPtr;
__device__ __forceinline__ Params load_params() {
#if defined(__HIP_DEVICE_COMPILE__)
    KParamsPtr kp = (KParamsPtr)__builtin_amdgcn_kernarg_segment_ptr(); asm volatile("" : "+s"(kp)); return *kp;
#else
    return Params{};
#endif
}
#if defined(MK_CG_SYNC)
#define GSYNC() grid.sync()
#else
#define GSYNC() xcd_barrier(xbar)
#endif
__global__ void __launch_bounds__(512, 2) mega_fwd(Params p_unused) {
    extern __shared__ __attribute__((aligned(16))) unsigned char lds_raw[];
    cg::grid_group grid = cg::this_grid();
    LAS unsigned char* lds = (LAS unsigned char*)lds_raw;
    volatile LAS unsigned* bst = (volatile LAS unsigned*)(lds + LDS_BYTES - 16);
    if (threadIdx.x == 0) { bst[0] = 0u; bst[1] = 0u; }
    __syncthreads();
    XcdBarrier xbar;
    { const Params p = load_params(); xbar = xcd_barrier_post((unsigned*)p.ws, bst); }
#if defined(MK_DUP_P0)
    { const Params p = load_params(); phase0(p, lds); }
    GSYNC();
#endif
    { const Params p = load_params(); phase0(p, lds); }
    GSYNC();
#if defined(MK_EXTRA_SYNCS)
    for (int i = 0; i < MK_EXTRA_SYNCS; ++i) GSYNC();
#endif
#pragma unroll 1
    for (int l = 0; l < 2; ++l) {
        {
            const Params p = load_params(); const int G = gridDim.x, c = obid();
            ab_phase(p.ws, WS_WIN + ((size_t)l * NIN + 3072) * D * 2);
            pg8::Gemm g{(const bf16*)(p.ws + WS_XN), (const bf16*)(p.ws + WS_WIN) + (size_t)l * NIN * D, M, 3072, D}; pg8::StaticOrder S; S.init(M, 3072, G, c);
            EpiIn E{(bf16*)(p.ws + WS_HG), (bf16*)(p.ws + WS_HZ), (bf16*)(p.ws + WS_HN), (float*)(p.ws + WS_AB), 0};
            pg8::gemm_phase<EpiIn, pg8::StaticOrder, true, true>(lds, g, S, E);
#if defined(MK_DUP_GIN)
            GSYNC();
            pg8::gemm_phase<EpiIn, pg8::StaticOrder, true, true>(lds, g, S, E);
#endif
        }
        GSYNC();
#if !defined(MK_SKIP_MIXER)
#if defined(MK_DUP_PREP_PRE)
        { const Params p = load_params(); prep_phase(p, l, lds, MK_DUP_PREP_PRE); }
        GSYNC();
#endif
#if !defined(MK_SKIP_PREP)
        { const Params p = load_params(); prep_phase(p, l, lds); }
        GSYNC();
#endif
#if defined(MK_DUP_PREP)
        { const Params p = load_params(); prep_phase(p, l, lds, MK_DUP_PREP); }
        GSYNC();
#endif
#if !defined(MK_SKIP_SCAN)
        { const Params p = load_params(); scan_na_phase(p, l, lds); }
        if (l == 0) grid.sync(); else GSYNC();
#endif
#if defined(MK_DUP_SCAN)
        { const Params p = load_params(); scan_na_phase<MK_DUP_SCAN>(p, l, lds, 1); }
        GSYNC();
#endif
#if defined(MK_DUP_NA)
        { const Params p = load_params(); scan_na_phase(p, l, lds, 2); }
        GSYNC();
#endif
        { const Params p = load_params(); combine_phase(p, l); }
        GSYNC();
#endif
        {
            const Params p = load_params(); const int G = gridDim.x, c = obid();
            pg8::Gemm g{(const bf16*)((unsigned char*)p.out + OUT_MIX), (const bf16*)(p.ws + WS_WOUT) + (size_t)l * D * D, M, D, D}; pg8::StaticOrder S; S.init(M, D, G, c);
            EpiRes E{(const bf16*)(p.ws + WS_XN), (bf16*)(p.ws + WS_YB), nullptr};
            pg8::gemm_phase<EpiRes, pg8::StaticOrder, true, true>(lds, g, S, E);
        }
        GSYNC();
        { const Params p = load_params(); ln_phase_b((const bf16*)(p.ws + WS_YB), nullptr, (bf16*)(p.ws + WS_XN), p.ln1_g + l * D, p.ln1_b + l * D); }
        GSYNC();
        {
            const Params p = load_params(); const int G = gridDim.x, c = obid();
            pg8::Gemm g{(const bf16*)(p.ws + WS_XN), (const bf16*)(p.ws + WS_W1) + (size_t)l * D * FF, M, FF, D}; pg8::StaticOrder S; S.init(M, FF, G, c);
            EpiUp E{(bf16*)(p.ws + WS_HB), p.b1 + l * FF};
            pg8::gemm_phase<EpiUp, pg8::StaticOrder, true, true>(lds, g, S, E);
#if defined(MK_DUP_GUP)
            GSYNC();
            pg8::gemm_phase<EpiUp, pg8::StaticOrder, true, true>(lds, g, S, E);
#endif
        }
        GSYNC();
        {
            const Params p = load_params(); const int G = gridDim.x, c = obid();
            pg8::Gemm g{(const bf16*)(p.ws + WS_HB), (const bf16*)(p.ws + WS_W2) + (size_t)l * D * FF, M, D, FF}; pg8::StaticOrder S; S.init(M, D, G, c);
            EpiRes E{(const bf16*)(p.ws + WS_XN), (bf16*)(p.ws + WS_YB), p.b2 + l * D};
            pg8::gemm_phase<EpiRes, pg8::StaticOrder, true, true>(lds, g, S, E);
        }
        GSYNC();
        { const Params p = load_params(); ln_phase_b((const bf16*)(p.ws + WS_YB), (l == 0) ? nullptr : p.out, (l == 0) ? (bf16*)(p.ws + WS_XN) : nullptr, p.ln2_g + l * D, p.ln2_b + l * D); }
        if (l == 0) GSYNC();
    }
#if defined(MK_SANITIZE)
    GSYNC();
    { const Params p = load_params(); for (size_t i = (size_t)obid() * 512 + otid(); i < (size_t)M * D; i += (size_t)gridDim.x * 512) { float v = p.out[i]; if (!(fabsf(v) < 1e30f)) p.out[i] = 100.0f; } }
#endif
}

extern "C" void kernel_launch(void* const* d_in, const int* in_sizes, int n_in, void* d_out, int out_size, void* d_ws, size_t ws_size, hipStream_t stream) {
    static int grid = 0;
    if (grid == 0) {
        if (n_in != 19 || out_size != M * D || ws_size < WS_END) { fprintf(stderr, "kernel_launch: unexpected shapes (n_in %d out %d ws %zu)\n", n_in, out_size, ws_size); grid = -1; return; }
        int dev = 0, cus = 0, per_cu = 0;
        hipGetDevice(&dev);
        hipDeviceGetAttribute(&cus, hipDeviceAttributeMultiprocessorCount, dev);
        hipFuncSetAttribute((const void*)mega_fwd, hipFuncAttributeMaxDynamicSharedMemorySize, LDS_BYTES);
        hipOccupancyMaxActiveBlocksPerMultiprocessor(&per_cu, (const void*)mega_fwd, 512, LDS_BYTES);
        if (per_cu < 1) { fprintf(stderr, "kernel_launch: occupancy query says %d blocks per CU\n", per_cu); per_cu = 1; }
        grid = cus;
        if (cus * 8 < M / 16) { fprintf(stderr, "kernel_launch: needs >= 256 CUs (ab_phase deals one 16-row group per wave)\n"); grid = -1; return; }
        (void)hipGetLastError();
    }
    if (grid < 0) return;
    Params p{};
    const float** pf = (const float**)&p;
    for (int i = 0; i < 19; ++i) pf[i] = (const float*)d_in[i];
    p.out = (float*)d_out; p.ws = (unsigned char*)d_ws;
    hipMemsetAsync(d_ws, 0, 16384, stream);
    void* args[] = {&p};
    hipError_t e = hipLaunchCooperativeKernel((const void*)mega_fwd, dim3(grid), dim3(512), args, LDS_BYTES, stream);
    if (e != hipSuccess) fprintf(stderr, "cooperative launch failed: %s (grid %d)\n", hipGetErrorString(e), grid);
}
```
